# Optimizing an MI355X kernel written in HIP

```python
import math, functools
import jax, jax.numpy as jnp
from jax import lax
import numpy as np

D_MODEL = 1024
BATCH = 8
SEQ = 2048
DEPTH = 2

N_A_LAYERS = DEPTH // 2
N_B_LAYERS = DEPTH - N_A_LAYERS
GDN_HEADS = D_MODEL // 128
GDN_DK = 128
GDN_DV = 128
GDN_WIDTH = GDN_HEADS * GDN_DV
CONV_WIDTH = 4
CHUNK = 64
DIFF_HEADS = D_MODEL // 128
DIFF_DK = 64
DIFF_DV = 2 * DIFF_DK
Q_BLOCK = 128
D_FF = 4 * D_MODEL
ROPE_THETA = 10000.0
EPS = 1e-6
GDN_IN_WIDTH = 4 * GDN_WIDTH + 2 * GDN_HEADS
Q_WIDTH = DIFF_HEADS * 2 * DIFF_DK
KV_WIDTH = DIFF_HEADS * 2 * DIFF_DK + DIFF_HEADS * DIFF_DV

kernel_name = 'yoco_gdn_diffattn_hybrid'


def rms_norm(x, w):
    xf = x.astype(jnp.float32)
    y = xf * lax.rsqrt(jnp.mean(xf * xf, axis=-1, keepdims=True) + EPS)
    return (y * w.astype(jnp.float32)).astype(x.dtype)


def l2_norm(x):
    return x * lax.rsqrt(jnp.sum(x * x, axis=-1, keepdims=True) + EPS)


def rope(t, positions):
    half = t.shape[-1] // 2
    freqs = ROPE_THETA ** (-jnp.arange(half, dtype=jnp.float32) / half)
    ang = positions.astype(jnp.float32)[:, :, None] * freqs
    ang = ang.reshape(ang.shape[:2] + (1,) * (t.ndim - 3) + (half,))
    cos, sin = jnp.cos(ang), jnp.sin(ang)
    tf = t.astype(jnp.float32)
    t1, t2 = tf[..., :half], tf[..., half:]
    return jnp.concatenate([t1 * cos - t2 * sin, t2 * cos + t1 * sin], axis=-1).astype(t.dtype)


def causal_conv(x, w):
    width = w.shape[0]
    seq = x.shape[1]
    xp = jnp.pad(x, ((0, 0), (width - 1, 0), (0, 0)))
    return sum(w[j] * xp[:, j:j + seq] for j in range(width))


def chunked_gated_delta_rule(q, k, v, beta, g):
    b, s, h, dk = q.shape
    dv = v.shape[-1]
    nc = s // CHUNK

    def chunks(t):
        return t.reshape((b, nc, CHUNK, h) + t.shape[3:]).swapaxes(2, 3)

    q, k, v, beta, g = chunks(q), chunks(k), chunks(v), chunks(beta), chunks(g)
    g_cum = jnp.cumsum(g, axis=-1)
    causal = jnp.tril(jnp.ones((CHUNK, CHUNK), dtype=bool))
    strict = jnp.tril(jnp.ones((CHUNK, CHUNK), dtype=bool), k=-1)
    decay = jnp.where(causal, jnp.exp(jnp.where(causal, g_cum[..., :, None] - g_cum[..., None, :], 0.0)), 0.0)
    k_beta = k * beta[..., None]
    kk = jnp.einsum('bnhcd,bnhed->bnhce', k_beta, k) * decay
    tri = jnp.where(strict, kk, 0.0) + jnp.eye(CHUNK, dtype=jnp.float32)
    solve = functools.partial(lax.linalg.triangular_solve, left_side=True, lower=True, unit_diagonal=True)
    u = solve(tri, v * beta[..., None])
    w = solve(tri, k_beta * jnp.exp(g_cum)[..., None])
    intra = jnp.einsum('bnhcd,bnhed->bnhce', q, k) * decay
    q_dec = q * jnp.exp(g_cum)[..., None]
    k_dec = k * jnp.exp(g_cum[..., -1:] - g_cum)[..., None]
    chunk_decay = jnp.exp(g_cum[..., -1])
    xs = tuple(jnp.moveaxis(t, 1, 0) for t in (q_dec, k_dec, w, u, intra, chunk_decay))

    def step(state, inp):
        qd, kd, wc, uc, ic, cd = inp
        v_new = uc - jnp.einsum('bhcd,bhdv->bhcv', wc, state)
        out = jnp.einsum('bhcd,bhdv->bhcv', qd, state) + jnp.einsum('bhce,bhev->bhcv', ic, v_new)
        state = state * cd[..., None, None] + jnp.einsum('bhcd,bhcv->bhdv', kd, v_new)
        return state, out

    state0 = jnp.zeros((b, h, dk, dv), jnp.float32)
    _, o = lax.scan(step, state0, xs)
    return o.transpose(1, 0, 3, 2, 4).reshape(b, s, h, dv)


def gated_deltanet(x, norm_w, w_in, conv_w, a_log, dt_bias, out_norm, w_out):
    b, s, _ = x.shape
    f32 = jnp.float32
    proj = rms_norm(x, norm_w) @ w_in
    qkv = jax.nn.silu(causal_conv(proj[..., :3 * GDN_WIDTH], conv_w)).astype(f32)
    z = proj[..., 3 * GDN_WIDTH:4 * GDN_WIDTH].astype(f32)
    b_raw = proj[..., 4 * GDN_WIDTH:4 * GDN_WIDTH + GDN_HEADS].astype(f32)
    a_raw = proj[..., 4 * GDN_WIDTH + GDN_HEADS:].astype(f32)
    q, k, v = jnp.split(qkv, 3, axis=-1)
    q = l2_norm(q.reshape(b, s, GDN_HEADS, GDN_DK)) * (GDN_DK ** -0.5)
    k = l2_norm(k.reshape(b, s, GDN_HEADS, GDN_DK))
    v = v.reshape(b, s, GDN_HEADS, GDN_DV)
    beta = jax.nn.sigmoid(b_raw)
    g = -jnp.exp(a_log.astype(f32)) * jax.nn.softplus(a_raw + dt_bias.astype(f32))
    o = chunked_gated_delta_rule(q, k, v, beta, g)
    o = rms_norm(o, out_norm) * jax.nn.silu(z.reshape(b, s, GDN_HEADS, GDN_DV))
    return o.reshape(b, s, GDN_WIDTH).astype(x.dtype) @ w_out


def shared_kv(x, kv_norm, w_kv, k_norm, positions):
    b, s, _ = x.shape
    kv = rms_norm(x, kv_norm) @ w_kv
    k = kv[..., :Q_WIDTH].reshape(b, s, DIFF_HEADS, 2, DIFF_DK)
    v = kv[..., Q_WIDTH:].reshape(b, s, DIFF_HEADS, DIFF_DV)
    k = rope(rms_norm(k, k_norm), positions)
    return k.transpose(0, 2, 1, 3, 4), v.transpose(0, 2, 1, 3)


def diff_attention(x, positions, k, v, norm_w, w_q, q_norm, lam_params, sub_norm, w_out, lam_init):
    b, s, _ = x.shape
    f32 = jnp.float32
    q = (rms_norm(x, norm_w) @ w_q).reshape(b, s, DIFF_HEADS, 2, DIFF_DK)
    q = rope(rms_norm(q, q_norm), positions).transpose(0, 2, 1, 3, 4)
    lp = lam_params.astype(f32)
    lam = jnp.exp(jnp.sum(lp[0] * lp[1])) - jnp.exp(jnp.sum(lp[2] * lp[3])) + lam_init
    scale = DIFF_DK ** -0.5
    outs = []
    for blk in range(s // Q_BLOCK):
        start, end = blk * Q_BLOCK, (blk + 1) * Q_BLOCK
        scores = jnp.einsum('bhqmd,bhkmd->bhmqk', q[:, :, start:end], k[:, :, :end]).astype(f32) * scale
        causal = jnp.arange(end)[None, :] <= (start + jnp.arange(Q_BLOCK))[:, None]
        probs = jax.nn.softmax(jnp.where(causal, scores, -1e30), axis=-1)
        diff = probs[:, :, 0] - lam * probs[:, :, 1]
        outs.append(jnp.einsum('bhqk,bhkv->bhqv', diff, v[:, :, :end].astype(f32)))
    o = jnp.concatenate(outs, axis=2)
    o = rms_norm(o, sub_norm) * (1.0 - lam_init)
    return o.transpose(0, 2, 1, 3).reshape(b, s, DIFF_HEADS * DIFF_DV).astype(x.dtype) @ w_out


def sq_relu_mlp(x, norm_w, w1, w2):
    h = jax.nn.relu(rms_norm(x, norm_w) @ w1)
    return (h * h) @ w2


def setup_inputs(seed: int = 0) -> dict:
    key = jax.random.key(seed)
    keys = jax.random.split(key, 21)
    f32 = jnp.float32

    def normal(k, shape, scale):
        return jax.random.normal(k, shape, f32) * scale

    def gain(k, shape):
        return 1.0 + 0.05 * jax.random.normal(k, shape, f32)

    x = normal(keys[0], (BATCH, SEQ, D_MODEL), 1.0)
    offset = jax.random.randint(keys[1], (BATCH, 1), 0, 4096, dtype=jnp.int32)
    positions = offset + jnp.arange(SEQ, dtype=jnp.int32)[None, :]
    a_norm = gain(keys[2], (N_A_LAYERS, D_MODEL))
    a_w_in = normal(keys[3], (N_A_LAYERS, D_MODEL, GDN_IN_WIDTH), D_MODEL ** -0.5)
    a_conv_w = normal(keys[4], (N_A_LAYERS, CONV_WIDTH, 3 * GDN_WIDTH), CONV_WIDTH ** -0.5)
    a_a_log = jnp.log(jax.random.uniform(keys[5], (N_A_LAYERS, GDN_HEADS), f32, 1.0, 16.0))
    dt = jnp.exp(jax.random.uniform(keys[6], (N_A_LAYERS, GDN_HEADS), f32, math.log(1e-3), math.log(1e-1)))
    a_dt_bias = dt + jnp.log(-jnp.expm1(-dt))
    a_out_norm = gain(keys[7], (N_A_LAYERS, GDN_DV))
    a_w_out = normal(keys[8], (N_A_LAYERS, GDN_WIDTH, D_MODEL), GDN_WIDTH ** -0.5)
    kv_norm = gain(keys[9], (D_MODEL,))
    w_kv = normal(keys[10], (D_MODEL, KV_WIDTH), D_MODEL ** -0.5)
    k_norm = gain(keys[11], (DIFF_DK,))
    b_norm = gain(keys[12], (N_B_LAYERS, D_MODEL))
    b_w_q = normal(keys[13], (N_B_LAYERS, D_MODEL, Q_WIDTH), D_MODEL ** -0.5)
    b_q_norm = gain(keys[14], (N_B_LAYERS, DIFF_DK))
    b_lambda = normal(keys[15], (N_B_LAYERS, 4, DIFF_DK), 0.1)
    b_sub_norm = gain(keys[16], (N_B_LAYERS, DIFF_DV))
    b_w_out = normal(keys[17], (N_B_LAYERS, DIFF_HEADS * DIFF_DV, D_MODEL), (DIFF_HEADS * DIFF_DV) ** -0.5)
    mlp_norm = gain(keys[18], (DEPTH, D_MODEL))
    mlp_w1 = normal(keys[19], (DEPTH, D_MODEL, D_FF), D_MODEL ** -0.5)
    mlp_w2 = normal(keys[20], (DEPTH, D_FF, D_MODEL), 0.5 * D_FF ** -0.5)
    return {'x': x, 'positions': positions,
            'a_norm': a_norm, 'a_w_in': a_w_in, 'a_conv_w': a_conv_w, 'a_a_log': a_a_log,
            'a_dt_bias': a_dt_bias, 'a_out_norm': a_out_norm, 'a_w_out': a_w_out,
            'kv_norm': kv_norm, 'w_kv': w_kv, 'k_norm': k_norm,
            'b_norm': b_norm, 'b_w_q': b_w_q, 'b_q_norm': b_q_norm, 'b_lambda': b_lambda,
            'b_sub_norm': b_sub_norm, 'b_w_out': b_w_out,
            'mlp_norm': mlp_norm, 'mlp_w1': mlp_w1, 'mlp_w2': mlp_w2}


def reference(x, positions, a_norm, a_w_in, a_conv_w, a_a_log, a_dt_bias, a_out_norm, a_w_out,
              kv_norm, w_kv, k_norm, b_norm, b_w_q, b_q_norm, b_lambda, b_sub_norm, b_w_out,
              mlp_norm, mlp_w1, mlp_w2):
    k_shared, v_shared = None, None
    for layer in range(DEPTH):
        if layer < N_A_LAYERS:
            x = x + gated_deltanet(x, a_norm[layer], a_w_in[layer], a_conv_w[layer], a_a_log[layer],
                                   a_dt_bias[layer], a_out_norm[layer], a_w_out[layer])
        else:
            if layer == N_A_LAYERS:
                k_shared, v_shared = shared_kv(x, kv_norm, w_kv, k_norm, positions)
            j = layer - N_A_LAYERS
            lam_init = 0.8 - 0.6 * math.exp(-0.3 * layer)
            x = x + diff_attention(x, positions, k_shared, v_shared, b_norm[j], b_w_q[j], b_q_norm[j],
                                   b_lambda[j], b_sub_norm[j], b_w_out[j], lam_init)
        x = x + sq_relu_mlp(x, mlp_norm[layer], mlp_w1[layer], mlp_w2[layer])
    return x
```

```cpp
#include <hip/hip_runtime.h>
#include <hip/hip_cooperative_groups.h>
#include <cstdio>
#include <cstdint>
namespace cg = cooperative_groups;
#ifndef INV_REPS
#define INV_REPS 1
#endif
__device__ __forceinline__ int fresh_lane() { int l; asm volatile("v_mbcnt_lo_u32_b32 %0, -1, 0\n\tv_mbcnt_hi_u32_b32 %0, -1, %0" : "=v"(l)); return l; }
namespace pg8 {
#define PG8_LAS __attribute__((address_space(3)))
typedef unsigned short bf16_t;
typedef short bf16x8 __attribute__((ext_vector_type(8)));
typedef float f32x4 __attribute__((ext_vector_type(4)));
typedef unsigned u32x4 __attribute__((ext_vector_type(4)));
constexpr int BM = 256, BK = 64, HALF = 128, HTB = HALF * BK * 2  , STAGE_BYTES = 8 * HTB, NXCD = 8, WGM = 8;

__host__ __device__ __forceinline__ int lds_byte(int r, int c) { const int st = (r >> 4) * 2 + (c >> 5), rr = r & 15, cc = c & 31, ob = rr * 64 + cc * 2; return st * 1024 + (ob ^ (((ob >> 9) & 1) << 5)); }
__host__ __device__ __forceinline__ void stage_rc(int b, int& R, int& C) { const int st = b / 1024, sb = b % 1024, swz = sb ^ (((sb >> 9) & 1) << 5); R = (st >> 1) * 16 + swz / 64; C = (st & 1) * 32 + (swz % 64) / 2; }
__host__ __device__ __forceinline__ int perm32(int rho) { const int n = rho >> 4, i = rho & 15; return 8 * (i >> 2) + 4 * n + (i & 3); }

struct Unit { int pm, pn; };
struct Gemm { const bf16_t* A; const bf16_t* Bt; int M, N, K; };

struct StaticOrder {
    int nM, nN, nwg, G, c;
    __host__ __device__ void init(int M, int N, int G_, int c_) { nM = M / BM; nN = N / BM; nwg = nM * nN; G = G_; c = c_; }
    __host__ __device__ bool next(int i, Unit& u) const {
        const long L = (long)i * G + c; if (L >= nwg) return false;
        int wgid = (int)L; { const int q = nwg / NXCD, r = nwg % NXCD, xcd = wgid % NXCD, off = wgid / NXCD; wgid = (xcd < r ? xcd * (q + 1) : r * (q + 1) + (xcd - r) * q) + off; }
        const int nig = WGM * nN, gid = wgid / nig, fm = gid * WGM, gsz = (nM - fm) < WGM ? (nM - fm) : WGM;
        u.pm = fm + ((wgid % nig) % gsz); u.pn = (wgid % nig) / gsz; return true;
    }
    __device__ __forceinline__ void a_ready(const Unit&) const {}
    __device__ __forceinline__ void done(const Unit&) const {}
};
__device__ __forceinline__ unsigned cvt_pk_bf16(float lo, float hi) { unsigned r; asm volatile("v_cvt_pk_bf16_f32 %0, %1, %2" : "=v"(r) : "v"(lo), "v"(hi)); return r; }
typedef float f32x2 __attribute__((ext_vector_type(2)));
typedef __bf16 bf16x2_tt __attribute__((ext_vector_type(2)));
typedef float f32x2_tt __attribute__((ext_vector_type(2)));
__device__ __forceinline__ unsigned pkbf(float lo, float hi) { f32x2_tt v = {lo, hi}; bf16x2_tt b = __builtin_convertvector(v, bf16x2_tt); return __builtin_bit_cast(unsigned, b); }
__device__ __forceinline__ float row_rs(const float* ss, int row) {
    const f32x4* p = (const f32x4*)(ss + (size_t)row * 16);
    const f32x4 a = p[0], b = p[1], c = p[2], d = p[3];
    const float s = ((a[0] + a[1]) + (a[2] + a[3])) + ((b[0] + b[1]) + (b[2] + b[3])) + ((c[0] + c[1]) + (c[2] + c[3])) + ((d[0] + d[1]) + (d[2] + d[3]));
    return rsqrtf(s * (1.0f / 1024.0f) + 1e-6f);
}
template <int ACT> struct EpiScaleBf16 {
    static constexpr bool PERM = true, AFTER_DRAIN = false;
    bf16_t* O; int ldc; bf16_t* O2; int ldc2; int split_tile; const PG8_LAS float* rsb;
    __device__ __forceinline__ void operator()(const f32x4 (&acc)[2][2][4][2], const Unit& u, int wr, int wc, int fr, int fq, int ui) const {
        const int row0 = u.pm * BM + wr * 64 + fr; bf16_t* base = O; int ld = ldc; int colt = u.pn * BM;
        if (u.pn >= split_tile) { base = O2; ld = ldc2; colt -= split_tile * BM; }
        const int col0 = colt + wc * 32 + 8 * fq;
#pragma unroll
        for (int ai = 0; ai < 2; ++ai)
#pragma unroll
            for (int m = 0; m < 4; ++m) { const int row = row0 + ai * HALF + m * 16; const float rs = rsb[ui * 256 + wr * 64 + fr + ai * HALF + m * 16]; bf16_t* rowp = base + (size_t)row * ld + col0;
#pragma unroll
                for (int bj = 0; bj < 2; ++bj) { f32x4 v0 = acc[ai][bj][m][0] * rs, v1 = acc[ai][bj][m][1] * rs;
                    if (ACT == 1) {
#pragma unroll
                        for (int e = 0; e < 4; ++e) { const float a = fmaxf(v0[e], 0.f), b = fmaxf(v1[e], 0.f); v0[e] = a * a; v1[e] = b * b; } }
                    u32x4 w; w.x = pkbf(v0[0], v0[1]); w.y = pkbf(v0[2], v0[3]); w.z = pkbf(v1[0], v1[1]); w.w = pkbf(v1[2], v1[3]);
                    *(u32x4*)(rowp + bj * HALF) = w; } }
    }
};
__device__ __forceinline__ float bfl_(unsigned u) { return __uint_as_float(u << 16); }
__device__ __forceinline__ float bfh_(unsigned u) { return __uint_as_float(u & 0xffff0000u); }
template <bool BASE_BF16, bool OUT_F32, bool WITH_B> struct EpiResid {
    static constexpr bool PERM = true, AFTER_DRAIN = false;
    const void* base; float* out; bf16_t* xb; float* ssn;
    __device__ __forceinline__ void operator()(const f32x4 (&acc)[2][2][4][2], const Unit& u, int wr, int wc, int fr, int fq, int) const {
        const int row0 = u.pm * BM + wr * 64 + fr; const int col0 = u.pn * BM + wc * 32 + 8 * fq;
#pragma unroll
        for (int ai = 0; ai < 2; ++ai)
#pragma unroll
            for (int m = 0; m < 4; ++m) { const int row = row0 + ai * HALF + m * 16; const size_t off = (size_t)row * 1024 + col0; float s = 0.f;
#pragma unroll
                for (int bj = 0; bj < 2; ++bj) { f32x4 b0, b1;
                    if (BASE_BF16) { const u32x4 bb = *(const u32x4*)((const bf16_t*)base + off + bj * HALF); b0 = (f32x4){bfl_(bb.x), bfh_(bb.x), bfl_(bb.y), bfh_(bb.y)}; b1 = (f32x4){bfl_(bb.z), bfh_(bb.z), bfl_(bb.w), bfh_(bb.w)}; }
                    else { b0 = __builtin_nontemporal_load((const f32x4*)((const float*)base + off + bj * HALF)); b1 = __builtin_nontemporal_load((const f32x4*)((const float*)base + off + bj * HALF + 4)); }
                    const f32x4 v0 = b0 + acc[ai][bj][m][0], v1 = b1 + acc[ai][bj][m][1];
                    if (OUT_F32) { __builtin_nontemporal_store(v0, (f32x4*)(out + off + bj * HALF)); __builtin_nontemporal_store(v1, (f32x4*)(out + off + bj * HALF + 4)); }
                    if (WITH_B) { u32x4 w; w.x = pkbf(v0[0], v0[1]); w.y = pkbf(v0[2], v0[3]); w.z = pkbf(v1[0], v1[1]); w.w = pkbf(v1[2], v1[3]); *(u32x4*)(xb + off + bj * HALF) = w;
                        s += (v0[0] * v0[0] + v0[1] * v0[1]) + (v0[2] * v0[2] + v0[3] * v0[3]) + (v1[0] * v1[0] + v1[1] * v1[1]) + (v1[2] * v1[2] + v1[3] * v1[3]); } }
                if (WITH_B) { s += __shfl_xor(s, 16); s += __shfl_xor(s, 32); if (fq == 0) ssn[(size_t)row * 16 + u.pn * 4 + wc] = s; } }
    }
};
struct EpiKVQ {
    static constexpr bool PERM = true, AFTER_DRAIN = false;
    bf16_t* O; const PG8_LAS float* rsb; const float* rope; const float* knorm; const float* qnorm;
    __device__ __forceinline__ void operator()(const f32x4 (&acc)[2][2][4][2], const Unit& u, int wr, int wc, int fr, int fq, int ui) const {
        const int row0 = u.pm * BM + wr * 64 + fr;
        if (u.pn >= 4 && u.pn < 8) {
            const int col0 = u.pn * BM + wc * 32 + 8 * fq;
#pragma unroll
            for (int ai = 0; ai < 2; ++ai)
#pragma unroll
                for (int m = 0; m < 4; ++m) { const int row = row0 + ai * HALF + m * 16; const float rs = rsb[ui * 256 + wr * 64 + fr + ai * HALF + m * 16]; bf16_t* rowp = O + (size_t)row * 3072 + col0;
#pragma unroll
                    for (int bj = 0; bj < 2; ++bj) { const f32x4 v0 = acc[ai][bj][m][0] * rs, v1 = acc[ai][bj][m][1] * rs;
                        u32x4 w; w.x = pkbf(v0[0], v0[1]); w.y = pkbf(v0[2], v0[3]); w.z = pkbf(v1[0], v1[1]); w.w = pkbf(v1[2], v1[3]); *(u32x4*)(rowp + bj * HALF) = w; } }
            return;
        }
        const bool isq = u.pn >= 8; const PG8_LAS float* nwl = rsb + 1024 + (isq ? 64 : 0) + 8 * fq; const float osc = isq ? 0.125f * 1.4426950408889634f : 1.0f;
        const int colg = u.pn * BM + wc * 64 + 8 * fq;
#pragma unroll
        for (int ai = 0; ai < 2; ++ai)
#pragma unroll
            for (int m = 0; m < 4; ++m) { const int row = row0 + ai * HALF + m * 16; const float rs = rsb[ui * 256 + wr * 64 + fr + ai * HALF + m * 16];
                const f32x4* rp = (const f32x4*)(rope + (size_t)row * 64 + 16 * fq);
                const f32x4 r0 = rp[0], r1 = rp[1], r2 = rp[2], r3 = rp[3];
                const float cs[8] = {r0[0], r0[2], r1[0], r1[2], r2[0], r2[2], r3[0], r3[2]}, sn[8] = {r0[1], r0[3], r1[1], r1[3], r2[1], r2[3], r3[1], r3[3]};
                float a[8], b[8]; float s2 = 0.f;
#pragma unroll
                for (int e = 0; e < 4; ++e) { a[e] = acc[ai][0][m][0][e] * rs; a[4 + e] = acc[ai][0][m][1][e] * rs; b[e] = acc[ai][1][m][0][e] * rs; b[4 + e] = acc[ai][1][m][1][e] * rs; }
#pragma unroll
                for (int e = 0; e < 8; ++e) s2 += a[e] * a[e] + b[e] * b[e];
                s2 += __shfl_xor(s2, 16); s2 += __shfl_xor(s2, 32);
                const float rn = rsqrtf(s2 * (1.0f / 64.0f) + 1e-6f) * osc;
                const f32x4 wa0 = *(const PG8_LAS f32x4*)nwl, wa1 = *(const PG8_LAS f32x4*)(nwl + 4), wb0 = *(const PG8_LAS f32x4*)(nwl + 32), wb1 = *(const PG8_LAS f32x4*)(nwl + 36);
                const float w1[8] = {wa0[0], wa0[1], wa0[2], wa0[3], wa1[0], wa1[1], wa1[2], wa1[3]}, w2[8] = {wb0[0], wb0[1], wb0[2], wb0[3], wb1[0], wb1[1], wb1[2], wb1[3]};
                float o1[8], o2[8];
#pragma unroll
                for (int e = 0; e < 8; ++e) { const float y1 = a[e] * rn * w1[e], y2 = b[e] * rn * w2[e]; o1[e] = y1 * cs[e] - y2 * sn[e]; o2[e] = y2 * cs[e] + y1 * sn[e]; }
                u32x4 wa, wb; wa.x = pkbf(o1[0], o1[1]); wa.y = pkbf(o1[2], o1[3]); wa.z = pkbf(o1[4], o1[5]); wa.w = pkbf(o1[6], o1[7]);
                wb.x = pkbf(o2[0], o2[1]); wb.y = pkbf(o2[2], o2[3]); wb.z = pkbf(o2[4], o2[5]); wb.w = pkbf(o2[6], o2[7]);
                bf16_t* rowp = O + (size_t)row * 3072 + colg; *(u32x4*)rowp = wa; *(u32x4*)(rowp + 32) = wb;
                asm volatile("" ::: "memory"); __builtin_amdgcn_sched_barrier(0); }
    }
};
template <class Epi, class Sched, bool ALIGN_EPI = false, bool SP2 = false>
__device__ __forceinline__ void gemm_phase(PG8_LAS unsigned char* lds, const Gemm g, const Sched& S, const Epi& E, int wave_in) {
    const int lane = fresh_lane(), wid = __builtin_amdgcn_readfirstlane(wave_in), tid = wid * 64 + lane, wr = wid >> 2, wc = wid & 3, fr = lane & 15, fq = lane >> 4;
    const int K = g.K, nt = K / BK;
    unsigned voffA[2], voffB[2];
#pragma unroll
    for (int i = 0; i < 2; ++i) { int R, C; stage_rc(tid * 16 + i * 8192, R, C); const int Rb = Epi::PERM ? ((R & ~31) + perm32(R & 31)) : R;
        voffA[i] = (unsigned)(R * K + C) * 2u; voffB[i] = (unsigned)(Rb * K + C) * 2u; }
    const size_t kstep = (size_t)(BK * 2);
    const size_t hstep = (size_t)HALF * K * 2;
    const size_t tstep = 2 * hstep;
    const unsigned ldsw = (unsigned)wid * 1024u;
    const int aoff = lds_byte(wr * 64 + fr, fq * 8), boff = lds_byte(wc * 32 + fr, fq * 8);
#define PG8_SA(b, h) (((b) * 2 + (h)) * HTB)
#define PG8_SB(b, h) ((4 + (b) * 2 + (h)) * HTB)
#define PG8_STAGE(bufoff, gbase, voff) do { _Pragma("unroll") for (int _i = 0; _i < 2; ++_i) \
        __builtin_amdgcn_global_load_lds((const unsigned*)((const char*)(gbase) + (voff)[_i]), (PG8_LAS unsigned*)(lds + (bufoff) + ldsw + _i * 8192), 16, 0, 0); } while (0)
#define PG8_LDA(dst, b, h) do { _Pragma("unroll") for (int m = 0; m < 4; ++m) _Pragma("unroll") for (int k = 0; k < 2; ++k) dst[m][k] = *(const PG8_LAS bf16x8*)(lds + PG8_SA(b, h) + aoff + m * 2048 + k * 1024); } while (0)
#define PG8_LDB(dst, b, h) do { _Pragma("unroll") for (int n = 0; n < 2; ++n) _Pragma("unroll") for (int k = 0; k < 2; ++k) dst[n][k] = *(const PG8_LAS bf16x8*)(lds + PG8_SB(b, h) + boff + n * 2048 + k * 1024); } while (0)
#define PG8_MMA(ai, bj, At, Bt) do { __builtin_amdgcn_s_setprio(1); _Pragma("unroll") for (int m = 0; m < 4; ++m) _Pragma("unroll") for (int n = 0; n < 2; ++n) _Pragma("unroll") for (int k = 0; k < 2; ++k) \
        acc[ai][bj][m][n] = __builtin_amdgcn_mfma_f32_16x16x32_bf16(Bt[n][k], At[m][k], acc[ai][bj][m][n], 0, 0, 0); __builtin_amdgcn_s_setprio(0); } while (0)
#define PG8_WAIT_V(n) asm volatile("s_waitcnt vmcnt(" #n ")" ::: "memory")
#define PG8_WAIT_L(n) asm volatile("s_waitcnt lgkmcnt(" #n ")" ::: "memory")
#define PG8_BAR __builtin_amdgcn_s_barrier()
#define PG8_SCHED __builtin_amdgcn_sched_barrier(0)
    Unit cur, nxt; int ui = 0;
    if (!S.next(0, cur)) return;
    f32x4 acc[2][2][4][2];
#pragma unroll
    for (int a = 0; a < 2; ++a)
#pragma unroll
        for (int b = 0; b < 2; ++b)
#pragma unroll
            for (int m = 0; m < 4; ++m)
#pragma unroll
                for (int n = 0; n < 2; ++n) acc[a][b][m][n] = (f32x4){0.f, 0.f, 0.f, 0.f};
    bf16x8 At[4][2], B0[2][2], B1[2][2];
    const char* cA = (const char*)g.A + (size_t)cur.pm * tstep; const char* cB = (const char*)g.Bt + (size_t)cur.pn * tstep;
    S.a_ready(cur);
    if constexpr (SP2) {
        PG8_STAGE(PG8_SB(0, 0), cB, voffB); PG8_STAGE(PG8_SB(0, 1), cB + hstep, voffB); PG8_STAGE(PG8_SA(0, 0), cA, voffA); PG8_STAGE(PG8_SA(0, 1), cA + hstep, voffA);
        if (wr == 1) PG8_BAR;
        PG8_WAIT_V(2); PG8_BAR;
        PG8_STAGE(PG8_SB(1, 0), cB + kstep, voffB); PG8_STAGE(PG8_SA(1, 0), cA + kstep, voffA); PG8_STAGE(PG8_SB(1, 1), cB + hstep + kstep, voffB);
        PG8_WAIT_V(6); PG8_BAR;
    } else {
        PG8_STAGE(PG8_SB(0, 0), cB, voffB); PG8_STAGE(PG8_SA(0, 0), cA, voffA); PG8_STAGE(PG8_SB(0, 1), cB + hstep, voffB); PG8_STAGE(PG8_SA(0, 1), cA + hstep, voffA);
        if (wr == 1) PG8_BAR;
        PG8_WAIT_V(4); PG8_BAR;
        PG8_STAGE(PG8_SB(1, 0), cB + kstep, voffB); PG8_STAGE(PG8_SA(1, 0), cA + kstep, voffA); PG8_STAGE(PG8_SB(1, 1), cB + hstep + kstep, voffB);
        PG8_WAIT_V(6); PG8_BAR;
    }
    for (;;) {
        const bool has_next = S.next(ui + 1, nxt);
        const char* nA = has_next ? (const char*)g.A + (size_t)nxt.pm * tstep : cA; const char* nB = has_next ? (const char*)g.Bt + (size_t)nxt.pn * tstep : cB;
        for (int t = 0; t < nt; t += 2) {
            const bool last = (t == nt - 2);
            const char* a1 = cA + (size_t)(t + 1) * kstep;
            const char* a2 = last ? nA : cA + (size_t)(t + 2) * kstep; const char* b2 = last ? nB : cB + (size_t)(t + 2) * kstep;
            const char* a3 = a2 + kstep; const char* b3 = b2 + kstep;
            if (last && has_next) S.a_ready(nxt);
            if constexpr (SP2) {
            PG8_LDB(B0, 0, 0); PG8_LDB(B1, 0, 1); PG8_SCHED; PG8_LDA(At, 0, 0); PG8_STAGE(PG8_SA(1, 1), a1 + hstep, voffA);
            PG8_WAIT_V(8); PG8_WAIT_L(0); PG8_BAR; PG8_MMA(0, 0, At, B0); PG8_MMA(0, 1, At, B1); PG8_BAR; PG8_SCHED;
            PG8_LDA(At, 0, 1); PG8_STAGE(PG8_SB(0, 0), b2, voffB); PG8_STAGE(PG8_SB(0, 1), b2 + hstep, voffB); PG8_STAGE(PG8_SA(0, 0), a2, voffA);
            PG8_WAIT_V(8); PG8_WAIT_L(0); PG8_BAR; PG8_MMA(1, 0, At, B0); PG8_MMA(1, 1, At, B1); PG8_BAR; PG8_SCHED;
            PG8_LDB(B0, 1, 0); PG8_LDB(B1, 1, 1); PG8_SCHED; PG8_LDA(At, 1, 0); PG8_STAGE(PG8_SA(0, 1), a2 + hstep, voffA);
            PG8_WAIT_V(8); PG8_WAIT_L(0); PG8_BAR; PG8_MMA(0, 0, At, B0); PG8_MMA(0, 1, At, B1); PG8_BAR; PG8_SCHED;
            PG8_LDA(At, 1, 1); PG8_STAGE(PG8_SB(1, 0), b3, voffB); PG8_STAGE(PG8_SB(1, 1), b3 + hstep, voffB); PG8_STAGE(PG8_SA(1, 0), a3, voffA);
            PG8_WAIT_V(8); PG8_WAIT_L(0); PG8_BAR; PG8_MMA(1, 0, At, B0); PG8_MMA(1, 1, At, B1); PG8_BAR; PG8_SCHED;
            } else {
            PG8_LDB(B0, 0, 0); PG8_SCHED; PG8_LDA(At, 0, 0); PG8_STAGE(PG8_SA(1, 1), a1 + hstep, voffA);
            PG8_WAIT_L(8); PG8_BAR; PG8_WAIT_L(0); PG8_MMA(0, 0, At, B0); PG8_BAR; PG8_SCHED;
            PG8_LDB(B1, 0, 1); PG8_STAGE(PG8_SB(0, 0), b2, voffB);
            PG8_BAR; PG8_WAIT_L(0); PG8_MMA(0, 1, At, B1); PG8_BAR;
            PG8_LDA(At, 0, 1); PG8_STAGE(PG8_SA(0, 0), a2, voffA);
            PG8_BAR; PG8_WAIT_L(0); PG8_MMA(1, 0, At, B0); PG8_BAR; PG8_SCHED;
            PG8_STAGE(PG8_SB(0, 1), b2 + hstep, voffB);
            PG8_WAIT_V(6); PG8_BAR; PG8_MMA(1, 1, At, B1); PG8_BAR;
            PG8_LDB(B0, 1, 0); PG8_SCHED; PG8_LDA(At, 1, 0); PG8_STAGE(PG8_SA(0, 1), a2 + hstep, voffA);
            PG8_WAIT_L(8); PG8_BAR; PG8_WAIT_L(0); PG8_MMA(0, 0, At, B0); PG8_BAR; PG8_SCHED;
            PG8_LDB(B1, 1, 1); PG8_STAGE(PG8_SB(1, 0), b3, voffB);
            PG8_BAR; PG8_WAIT_L(0); PG8_MMA(0, 1, At, B1); PG8_BAR;
            PG8_LDA(At, 1, 1); PG8_STAGE(PG8_SA(1, 0), a3, voffA);
            PG8_BAR; PG8_WAIT_L(0); PG8_MMA(1, 0, At, B0); PG8_BAR; PG8_SCHED;
            PG8_STAGE(PG8_SB(1, 1), b3 + hstep, voffB);
            PG8_WAIT_V(6); PG8_BAR; PG8_MMA(1, 1, At, B1); PG8_BAR;
            }
        }
        if constexpr (ALIGN_EPI) { if (wr == 0) PG8_BAR; }
        if constexpr (!Epi::AFTER_DRAIN) { E(acc, cur, wr, wc, fr, fq, ui); S.done(cur); }
        if (!has_next) break;
#pragma unroll
        for (int a = 0; a < 2; ++a)
#pragma unroll
            for (int b = 0; b < 2; ++b)
#pragma unroll
                for (int m = 0; m < 4; ++m)
#pragma unroll
                    for (int n = 0; n < 2; ++n) acc[a][b][m][n] = (f32x4){0.f, 0.f, 0.f, 0.f};
        cur = nxt; cA = nA; cB = nB; ++ui;
        if constexpr (ALIGN_EPI) { if (wr == 1) PG8_BAR; }
    }
    PG8_WAIT_V(0);
    if constexpr (!ALIGN_EPI) { if (wr == 0) PG8_BAR; }
    PG8_BAR;
    if constexpr (Epi::AFTER_DRAIN) { E.fused(acc, cur, wr, wc, fr, fq, lds, wid, lane); S.done(cur); }
#undef PG8_SA
#undef PG8_SB
#undef PG8_STAGE
#undef PG8_LDA
#undef PG8_LDB
#undef PG8_MMA
#undef PG8_WAIT_V
#undef PG8_WAIT_L
#undef PG8_BAR
#undef PG8_SCHED
}
}
#include <hip/hip_bf16.h>
#include <cmath>
namespace attn_body {
using bf16=__hip_bfloat16;
using bf16x8=__attribute__((ext_vector_type(8)))short;
using s16x4=__attribute__((ext_vector_type(4)))short;
using f32x16=__attribute__((ext_vector_type(16)))float;
using u32x4=__attribute__((ext_vector_type(4)))unsigned;
constexpr int BATCH=8,SEQ=2048,D=64,PQ=3072,PO=1024;
constexpr int NW=8,QBLK=32,QB=QBLK*NW,KVBLK=64,NQB=SEQ/QB;
constexpr int ATTN_UNIT_ROWS=QB;
__device__ __forceinline__ int crow(int r,int hi){return (r&3)+8*(r>>2)+4*hi;}
#define SBAR() __builtin_amdgcn_sched_barrier(0)
__device__ __forceinline__ void cmask(f32x16&p0,f32x16&p1,int jb,int qrel,int hi){
  const float NEG=-INFINITY; int kb=64*jb+4*hi;
  #pragma unroll
  for(int r=0;r<16;++r){int kv=kb+(r&3)+8*(r>>2); if(kv>qrel)p0[r]=NEG; if(kv+32>qrel)p1[r]=NEG;}
}

constexpr int NSLOT=3, SLOTB=8192;
constexpr int LDS_K=0, LDS_V=NSLOT*SLOTB, LDS_WS=2*NSLOT*SLOTB, LDS_OST=LDS_WS+NW*64*4, LDS_BYTES=LDS_OST+2*NW*4096;
constexpr float C2=0.125f*1.4426950408889634f;
__device__ __forceinline__ void glds16(const void*gsrc,unsigned lds_dst){unsigned keep;
  asm volatile("s_mov_b32 %0, m0\n\ts_mov_b32 m0, %2\n\ts_nop 0\n\tglobal_load_lds_dwordx4 %1, off\n\ts_mov_b32 m0, %0":"=&s"(keep):"v"(gsrc),"s"(lds_dst):"memory");}
__device__ __forceinline__ float max3f(float a,float b,float c){float r;asm("v_max3_f32 %0, %1, %2, %3":"=v"(r):"v"(a),"v"(b),"v"(c));return r;}
__device__ __forceinline__ float max2f(float a,float b){float r;asm("v_max_f32_e32 %0, %1, %2":"=v"(r):"v"(a),"v"(b));return r;}
__device__ __forceinline__ float fadd_s(float a,float b){float r;asm("v_add_f32_e32 %0, %1, %2":"=v"(r):"v"(a),"v"(b));return r;}
__device__ __forceinline__ float fsub_s(float a,float b){float r;asm("v_sub_f32_e32 %0, %1, %2":"=v"(r):"v"(a),"v"(b));return r;}
typedef float f32x2_t __attribute__((ext_vector_type(2))); typedef __bf16 bf16x2_t __attribute__((ext_vector_type(2)));
__device__ __forceinline__ unsigned cvtpk_s(float lo,float hi){f32x2_t v={lo,hi};bf16x2_t b=__builtin_convertvector(v,bf16x2_t);return __builtin_bit_cast(unsigned,b);}
#define WAIT_BAR(N) asm volatile("s_waitcnt vmcnt(" #N ") lgkmcnt(0)\n\ts_barrier":::"memory")

__device__ __forceinline__ void qkt(f32x16&p0,f32x16&p1,const char*Kslot,const bf16x8*qr,const f32x16&negm,int r32,int hi){
  const char*kb=Kslot+hi*1024+r32*16;
  #pragma unroll
  for(int d0=0;d0<4;++d0){
    const bf16x8 b0=*reinterpret_cast<const bf16x8*>(kb+d0*2048);
    const bf16x8 b1=*reinterpret_cast<const bf16x8*>(kb+d0*2048+512);
    if(d0==0){p0=__builtin_amdgcn_mfma_f32_32x32x16_bf16(b0,qr[0],negm,0,0,0);p1=__builtin_amdgcn_mfma_f32_32x32x16_bf16(b1,qr[0],negm,0,0,0);}
    else{p0=__builtin_amdgcn_mfma_f32_32x32x16_bf16(b0,qr[d0],p0,0,0,0);p1=__builtin_amdgcn_mfma_f32_32x32x16_bf16(b1,qr[d0],p1,0,0,0);}}
}
typedef __attribute__((address_space(3))) const char* lds_cptr;
typedef short v4i16_t __attribute__((ext_vector_type(4)));
__device__ __forceinline__ void kload8(bf16x8*kf,lds_cptr kp){
  kf[0]=*(const __attribute__((address_space(3))) bf16x8*)(kp);      kf[1]=*(const __attribute__((address_space(3))) bf16x8*)(kp+512);
  kf[2]=*(const __attribute__((address_space(3))) bf16x8*)(kp+2048); kf[3]=*(const __attribute__((address_space(3))) bf16x8*)(kp+2560);
  kf[4]=*(const __attribute__((address_space(3))) bf16x8*)(kp+4096); kf[5]=*(const __attribute__((address_space(3))) bf16x8*)(kp+4608);
  kf[6]=*(const __attribute__((address_space(3))) bf16x8*)(kp+6144); kf[7]=*(const __attribute__((address_space(3))) bf16x8*)(kp+6656);
}
__device__ __forceinline__ void kload2(bf16x8*kf,lds_cptr kp,int j){ kf[2*j]=*(const __attribute__((address_space(3))) bf16x8*)(kp+j*2048); kf[2*j+1]=*(const __attribute__((address_space(3))) bf16x8*)(kp+j*2048+512); }
__device__ __forceinline__ s16x4 vtr(lds_cptr p){ return __builtin_bit_cast(s16x4,__builtin_amdgcn_ds_read_tr16_b64_v4i16((__attribute__((address_space(3))) v4i16_t*)p)); }
__device__ __forceinline__ float rowmax(const f32x16&p0,const f32x16&p1){
  float a=max3f(p0[0],p0[1],p1[0]),b=max3f(p0[2],p0[3],p1[1]);a=max3f(a,p1[2],p1[3]);
  #pragma unroll
  for(int r=4;r<16;r+=4){a=max3f(a,p0[r],p0[r+1]);b=max3f(b,p0[r+2],p0[r+3]);a=max3f(a,p1[r],p1[r+1]);b=max3f(b,p1[r+2],p1[r+3]);}
  const float m=max2f(a,b);
  auto rr=__builtin_amdgcn_permlane32_swap(__float_as_uint(m),__float_as_uint(m),false,false);
  return max2f(__uint_as_float(rr[0]),__uint_as_float(rr[1]));
}
__device__ __forceinline__ void pv(f32x16*o,int vb,bf16x8 pa0,bf16x8 pa1,bf16x8 pa2,bf16x8 pa3){
  #pragma unroll
  for(int d0=0;d0<2;++d0){s16x4 lo[4],hi[4];
    #pragma unroll
    for(int ks=0;ks<4;++ks){
      asm volatile("ds_read_b64_tr_b16 %0,%1 offset:%c2":"=&v"(lo[ks]):"v"(vb),"i"(d0*4096+ks*1024):"memory");
      asm volatile("ds_read_b64_tr_b16 %0,%1 offset:%c2":"=&v"(hi[ks]):"v"(vb),"i"(d0*4096+ks*1024+512):"memory");}
    asm volatile("s_waitcnt lgkmcnt(0)":::"memory");SBAR();
    #define PK(k) (bf16x8){lo[k][0],lo[k][1],lo[k][2],lo[k][3],hi[k][0],hi[k][1],hi[k][2],hi[k][3]}
    o[d0]=__builtin_amdgcn_mfma_f32_32x32x16_bf16(pa0,PK(0),o[d0],0,0,0);
    o[d0]=__builtin_amdgcn_mfma_f32_32x32x16_bf16(pa1,PK(1),o[d0],0,0,0);
    o[d0]=__builtin_amdgcn_mfma_f32_32x32x16_bf16(pa2,PK(2),o[d0],0,0,0);
    o[d0]=__builtin_amdgcn_mfma_f32_32x32x16_bf16(pa3,PK(3),o[d0],0,0,0);
    #undef PK
  }
}

#ifndef ATTN_STORE16
#define ATTN_STORE16(p,v) (*(u32x4*)(p)=(v))
#endif
template<int THRL> __device__ __forceinline__ void attn_unit(int b,int h,int qb,const bf16*Q,const bf16*__restrict__ K,const bf16*__restrict__ V,bf16*O,char*shm,int mode,int hfsel,float lam,bool fin,const float*__restrict__ subw){
  int lane; asm volatile("v_mbcnt_lo_u32_b32 %0, -1, 0\n\tv_mbcnt_hi_u32_b32 %0, -1, %0" : "=v"(lane)); const int r32=lane&31,hi=lane>>5; const int wid=__builtin_amdgcn_readfirstlane(h);
  const long rowbase=(long)b*SEQ; const int q0=qb*QB;
  const bf16*Qw=Q+(rowbase+q0+wid*QBLK)*PQ;
  const bf16*Kh=K+rowbase*PQ,*Vh=V+rowbase*PQ;
  const unsigned lds0=(unsigned)(uintptr_t)shm;
  float*wsf=(float*)(shm+LDS_WS)+wid*64;
  const bf16*ksrc=Kh+(long)lane*PQ+wid*8;
  const bf16*vsrc=Vh+(long)(16*(wid&3)+(lane>>2))*PQ+(wid>>2)*32+(lane&3)*8;
  const unsigned kdst=lds0+LDS_K+wid*1024, vdst=lds0+LDS_V+wid*1024;
  #define DMA_K(t,slot) glds16(ksrc+(long)(t)*KVBLK*PQ,(unsigned)__builtin_amdgcn_readfirstlane(kdst+(slot)))
  #define DMA_V(t,slot) glds16(vsrc+(long)(t)*KVBLK*PQ,(unsigned)__builtin_amdgcn_readfirstlane(vdst+(slot)))
  const int vb0=(int)(lds0+LDS_V)+((lane>>4)&1)*32+(lane&3)*8+(4*hi+((lane&15)>>2))*64;
  const char*Kbase=shm+LDS_K; bf16x8 kf[8];
  const lds_cptr shm3=(lds_cptr)shm; const lds_cptr kp0=shm3+LDS_K+hi*1024+r32*16; const lds_cptr vp0=shm3+LDS_V+((lane>>4)&1)*32+(lane&3)*8+(4*hi+((lane&15)>>2))*64;
  const int NT=(q0+QB)/KVBLK;
  DMA_K(0,0);DMA_V(0,0);DMA_K(1,SLOTB);
  bf16x8 qr[4];
  #pragma unroll
  for(int d0=0;d0<4;++d0)qr[d0]=*reinterpret_cast<const bf16x8*>(&Qw[(long)r32*PQ+d0*16+hi*8]);
  float mhat=0.f,l_reg=0.f;float zz_;asm volatile("v_mov_b32 %0, 0":"=v"(zz_));f32x16 o[2];f32x16 negm;
  #pragma unroll
  for(int r=0;r<16;++r){o[0][r]=zz_;o[1][r]=zz_;negm[r]=zz_;}
  asm volatile("":"+v"(negm));
  const int qrel=wid*QBLK+r32;
  #define CMASK(P0,P1,t) do{int jb_=(t)-(NT-4); if(jb_>=0)cmask(P0,P1,jb_,qrel,hi);}while(0)
  bool resc=false;
  #define START(P0,P1) do{ const float rm=rowmax(P0,P1); resc=false; \
    { const float dl=rm; mhat=fadd_s(mhat,dl); \
      _Pragma("unroll") for(int r=0;r<16;++r){P0[r]=fsub_s(P0[r],dl);P1[r]=fsub_s(P1[r],dl);} \
      _Pragma("unroll") for(int r=0;r<16;++r)negm[r]=-mhat; asm volatile("":"+v"(negm)); } \
    _Pragma("unroll") for(int r=0;r<16;++r)P0[r]=__builtin_amdgcn_exp2f(P0[r]); }while(0)
  #define RESC() do{ if(resc){ asm volatile("s_waitcnt lgkmcnt(0)":::"memory"); \
      _Pragma("unroll") for(int d_=0;d_<2;++d_) _Pragma("unroll") for(int r=0;r<16;++r)o[d_][r]*=wsf[crow(r,hi)]; } }while(0)
  f32x16 pA0,pA1,pB0,pB1;
  int sl_prev=0,sl_cur=0,sl_next=SLOTB;
  #define ROT() do{sl_prev=sl_cur;sl_cur=sl_next;sl_next=(sl_next==(NSLOT-1)*SLOTB)?0:sl_next+SLOTB;}while(0)
  DMA_K(2,2*SLOTB);
  WAIT_BAR(3);
  qkt(pA0,pA1,Kbase,qr,negm,r32,hi);asm volatile("s_nop 15\n\ts_nop 7":"+v"(pA0),"+v"(pA1));CMASK(pA0,pA1,0);
  START(pA0,pA1);
  _Pragma("unroll") for(int r=0;r<16;++r)pA1[r]=__builtin_amdgcn_exp2f(pA1[r]);
  WAIT_BAR(0);
  DMA_K(3,0);DMA_V(1,SLOTB);
  ROT();
  kload8(kf,kp0+sl_cur);
  WAIT_BAR(2);
  s16x4 vlo[8],vhi[8]; u32x4 pw0,pw1,pw2,pw3;
  #define PKW(P,B) cvtpk_s(P[B],P[B+1])
  #define PAF(k) __builtin_bit_cast(bf16x8,pw##k)
  #define VFR(i) (bf16x8){vlo[i][0],vlo[i][1],vlo[i][2],vlo[i][3],vhi[i][0],vhi[i][1],vhi[i][2],vhi[i][3]}
  #define PIN(x) asm volatile("":"+v"(x))
  #define MX3(a,b,c) __builtin_fmaxf(__builtin_fmaxf((a),(b)),(c))
  #define GAPA(MF,A0,A1,A2,A3,W0,W1,PW) do{ MF; sacc+=A0; sacc+=A1; sacc+=A2; sacc+=A3; PIN(sacc); W0; W1; PIN(PW); SBAR(); }while(0)
  #define EX(v) __builtin_amdgcn_exp2f(v)
  #define GAPB(MF,X,B) do{ MF; X[B]=EX(X[B]); X[B+1]=EX(X[B+1]); X[B+2]=EX(X[B+2]); X[B+3]=EX(X[B+3]); PIN(X); SBAR(); }while(0)
  #define VRD(i) do{ vlo[i]=vtr(vp_+(((i)>>2)*4096+((i)&3)*1024)); vhi[i]=vtr(vp_+(((i)>>2)*4096+((i)&3)*1024+512)); }while(0)
  #define KRD(G,j) do{ if(G){ kload2(kf,kp0+sl_next,j); SBAR(); } }while(0)
  #define STEP(C0,C1,P0,P1,t,GK,GV,GL) do{ SBAR(); \
    const lds_cptr vp_=vp0+sl_prev; \
    VRD(0); SBAR(); float sacc=(P0[0]+P0[1]); \
    GAPA(C0=__builtin_amdgcn_mfma_f32_32x32x16_bf16(kf[0],qr[0],negm,0,0,0), P0[2],P0[3],P0[4],P0[5],     pw0[0]=PKW(P0,0), pw0[1]=PKW(P0,2), pw0); \
    VRD(4); SBAR(); GAPA(C1=__builtin_amdgcn_mfma_f32_32x32x16_bf16(kf[1],qr[0],negm,0,0,0), P0[6],P0[7],P0[8],P0[9],     pw0[2]=PKW(P0,4), pw0[3]=PKW(P0,6), pw0); \
    VRD(1); SBAR(); GAPA(C0=__builtin_amdgcn_mfma_f32_32x32x16_bf16(kf[2],qr[1],C0,0,0,0),   P0[10],P0[11],P0[12],P0[13], pw1[0]=PKW(P0,8), pw1[1]=PKW(P0,10), pw1); \
    VRD(5); SBAR(); GAPA(C1=__builtin_amdgcn_mfma_f32_32x32x16_bf16(kf[3],qr[1],C1,0,0,0),   P0[14],P0[15],P1[0],P1[1],   pw1[2]=PKW(P0,12),pw1[3]=PKW(P0,14), pw1); \
    VRD(2); SBAR(); GAPA(C0=__builtin_amdgcn_mfma_f32_32x32x16_bf16(kf[4],qr[2],C0,0,0,0),   P1[2],P1[3],P1[4],P1[5],     pw2[0]=PKW(P1,0), pw2[1]=PKW(P1,2), pw2); \
    VRD(6); SBAR(); GAPA(C1=__builtin_amdgcn_mfma_f32_32x32x16_bf16(kf[5],qr[2],C1,0,0,0),   P1[6],P1[7],P1[8],P1[9],     pw2[2]=PKW(P1,4), pw2[3]=PKW(P1,6), pw2); \
    VRD(3); SBAR(); GAPA(C0=__builtin_amdgcn_mfma_f32_32x32x16_bf16(kf[6],qr[3],C0,0,0,0),   P1[10],P1[11],P1[12],P1[13], pw3[0]=PKW(P1,8), pw3[1]=PKW(P1,10), pw3); \
    VRD(7); SBAR(); GAPA(C1=__builtin_amdgcn_mfma_f32_32x32x16_bf16(kf[7],qr[3],C1,0,0,0),   P1[14],P1[15],0.f,0.f,       pw3[2]=PKW(P1,12),pw3[3]=PKW(P1,14), pw3); \
    l_reg+=sacc; \
    if(GK){DMA_K((t)+3,sl_cur);} if(GV){DMA_V((t)+1,sl_next);} \
    CMASK(C0,C1,t); \
    { float a=MX3(C0[0],C0[1],C1[0]),b=MX3(C0[2],C0[3],C1[1]); a=MX3(a,C1[2],C1[3]); \
      _Pragma("unroll") for(int r=4;r<16;r+=4){a=MX3(a,C0[r],C0[r+1]);b=MX3(b,C0[r+2],C0[r+3]);a=MX3(a,C1[r],C1[r+1]);b=MX3(b,C1[r+2],C1[r+3]);} \
      float rm=__builtin_fmaxf(a,b); { auto rr=__builtin_amdgcn_permlane32_swap(__float_as_uint(rm),__float_as_uint(rm),false,false); rm=__builtin_fmaxf(__uint_as_float(rr[0]),__uint_as_float(rr[1])); } \
      resc=false; \
      if(__builtin_expect(__any(rm>(float)THRL),0)){ const float dl=__builtin_fmaxf(rm,0.f); mhat+=dl; \
        _Pragma("unroll") for(int r=0;r<16;++r){C0[r]-=dl;C1[r]-=dl;} \
        _Pragma("unroll") for(int r=0;r<16;++r)negm[r]=-mhat; asm volatile("":"+v"(negm)); \
        const float f=__builtin_amdgcn_exp2f(-dl); l_reg*=f; if(hi==0)wsf[r32]=f; resc=true; } } \
    SBAR(); \
    GAPB(o[0]=__builtin_amdgcn_mfma_f32_32x32x16_bf16(PAF(0),VFR(0),o[0],0,0,0), C0,0); \
    GAPB(o[1]=__builtin_amdgcn_mfma_f32_32x32x16_bf16(PAF(0),VFR(4),o[1],0,0,0), C0,4); \
    KRD(GL,0); GAPB(o[0]=__builtin_amdgcn_mfma_f32_32x32x16_bf16(PAF(1),VFR(1),o[0],0,0,0), C0,8); \
    KRD(GL,1); GAPB(o[1]=__builtin_amdgcn_mfma_f32_32x32x16_bf16(PAF(1),VFR(5),o[1],0,0,0), C0,12); \
    KRD(GL,2); GAPB(o[0]=__builtin_amdgcn_mfma_f32_32x32x16_bf16(PAF(2),VFR(2),o[0],0,0,0), C1,0); \
    KRD(GL,3); GAPB(o[1]=__builtin_amdgcn_mfma_f32_32x32x16_bf16(PAF(2),VFR(6),o[1],0,0,0), C1,4); \
    GAPB(o[0]=__builtin_amdgcn_mfma_f32_32x32x16_bf16(PAF(3),VFR(3),o[0],0,0,0), C1,8); \
    GAPB(o[1]=__builtin_amdgcn_mfma_f32_32x32x16_bf16(PAF(3),VFR(7),o[1],0,0,0), C1,12); \
    }while(0)
  int t=1;
  #undef CMASK
  #define CMASK(P0,P1,t) do{}while(0)
  for(;t+5<NT;t+=2){
    STEP(pB0,pB1,pA0,pA1,t,true,true,true);     WAIT_BAR(2); RESC(); ROT();
    STEP(pA0,pA1,pB0,pB1,t+1,true,true,true);   WAIT_BAR(2); RESC(); ROT();
  }
  #undef CMASK
  #define CMASK(P0,P1,t) do{int jb_=(t)-(NT-4); if(jb_>=0)cmask(P0,P1,jb_,qrel,hi);}while(0)
  #define ENDW(tt) do{ if((tt)+3<NT){WAIT_BAR(2);} else if((tt)+2<NT){WAIT_BAR(1);} else {WAIT_BAR(0);} }while(0)
  for(;t+1<NT;t+=2){
    STEP(pB0,pB1,pA0,pA1,t,(t+3<NT),(t+1<NT),(t+1<NT));       ENDW(t);   RESC(); ROT();
    STEP(pA0,pA1,pB0,pB1,t+1,(t+4<NT),(t+2<NT),(t+2<NT));     ENDW(t+1); RESC(); ROT();
  }
  STEP(pB0,pB1,pA0,pA1,NT-1,false,false,false); RESC();
  { float sacc=pB0[0]+pB0[1]; _Pragma("unroll") for(int r=2;r<16;++r)sacc+=pB0[r]; _Pragma("unroll") for(int r=0;r<16;++r)sacc+=pB1[r]; l_reg+=sacc;
    pw0=(u32x4){PKW(pB0,0),PKW(pB0,2),PKW(pB0,4),PKW(pB0,6)};pw1=(u32x4){PKW(pB0,8),PKW(pB0,10),PKW(pB0,12),PKW(pB0,14)};pw2=(u32x4){PKW(pB1,0),PKW(pB1,2),PKW(pB1,4),PKW(pB1,6)};pw3=(u32x4){PKW(pB1,8),PKW(pB1,10),PKW(pB1,12),PKW(pB1,14)};
    SBAR(); pv(o,vb0+sl_cur,PAF(0),PAF(1),PAF(2),PAF(3)); }
  #undef PKW
  #undef PAF
  #undef VFR
  #undef PIN
  #undef MX3
  #undef GAPA
  #undef GAPB
  #undef EX
  #undef VRD
  #undef KRD
  #undef STEP
  #undef ENDW
  {auto rr=__builtin_amdgcn_permlane32_swap(__float_as_uint(l_reg),__float_as_uint(l_reg),false,false);l_reg=__uint_as_float(rr[0])+__uint_as_float(rr[1]);}
  if(hi==0)wsf[32+r32]=l_reg;asm volatile("s_waitcnt lgkmcnt(0)":::"memory");
  float rli[16];
  #pragma unroll
  for(int r=0;r<16;++r)rli[r]=__builtin_amdgcn_rcpf(wsf[32+crow(r,hi)]);
  { bf16*stg=(bf16*)(shm+LDS_OST+hfsel*(NW*4096))+wid*2048;
    #pragma unroll
    for(int r=0;r<16;++r){const int orow=crow(r,hi);
      #pragma unroll
      for(int d0=0;d0<2;++d0){ const int idx=orow*64+d0*32+r32; float val=o[d0][r]*rli[r]; if(mode) val=__bfloat162float(stg[idx])-lam*val; stg[idx]=__float2bfloat16(val); } }
    asm volatile("s_waitcnt lgkmcnt(0)":::"memory");
    if(fin){ const bf16*s0=(const bf16*)(shm+LDS_OST)+wid*2048; const bf16*s1=s0+NW*2048;
      bf16*Ow=O+(rowbase+q0+wid*QBLK)*PO; const int ch=lane&7;
      float w0[8],w1[8];
      #pragma unroll
      for(int e=0;e<8;++e){ w0[e]=subw[ch*8+e]; w1[e]=subw[64+ch*8+e]; }
      #pragma unroll
      for(int i=0;i<4;++i){ const int row=i*8+(lane>>3);
        const u32x4 a=*(const u32x4*)(s0+row*64+ch*8), c=*(const u32x4*)(s1+row*64+ch*8);
        float x0[8]={__uint_as_float(a[0]<<16),__uint_as_float(a[0]&0xffff0000u),__uint_as_float(a[1]<<16),__uint_as_float(a[1]&0xffff0000u),__uint_as_float(a[2]<<16),__uint_as_float(a[2]&0xffff0000u),__uint_as_float(a[3]<<16),__uint_as_float(a[3]&0xffff0000u)};
        float x1[8]={__uint_as_float(c[0]<<16),__uint_as_float(c[0]&0xffff0000u),__uint_as_float(c[1]<<16),__uint_as_float(c[1]&0xffff0000u),__uint_as_float(c[2]<<16),__uint_as_float(c[2]&0xffff0000u),__uint_as_float(c[3]<<16),__uint_as_float(c[3]&0xffff0000u)};
        float ss=0.f;
        #pragma unroll
        for(int e=0;e<8;++e) ss+=x0[e]*x0[e]+x1[e]*x1[e];
        ss+=__shfl_xor(ss,1); ss+=__shfl_xor(ss,2); ss+=__shfl_xor(ss,4);
        const float rs=rsqrtf(ss*(1.0f/128.0f)+1e-6f);
        u32x4 v0,v1;
        v0[0]=cvtpk_s(x0[0]*rs*w0[0],x0[1]*rs*w0[1]); v0[1]=cvtpk_s(x0[2]*rs*w0[2],x0[3]*rs*w0[3]); v0[2]=cvtpk_s(x0[4]*rs*w0[4],x0[5]*rs*w0[5]); v0[3]=cvtpk_s(x0[6]*rs*w0[6],x0[7]*rs*w0[7]);
        v1[0]=cvtpk_s(x1[0]*rs*w1[0],x1[1]*rs*w1[1]); v1[1]=cvtpk_s(x1[2]*rs*w1[2],x1[3]*rs*w1[3]); v1[2]=cvtpk_s(x1[4]*rs*w1[4],x1[5]*rs*w1[5]); v1[3]=cvtpk_s(x1[6]*rs*w1[6],x1[7]*rs*w1[7]);
        ATTN_STORE16(Ow+(long)row*PO+ch*8,v0); ATTN_STORE16(Ow+(long)row*PO+64+ch*8,v1); } } }
  asm volatile("s_waitcnt lgkmcnt(0)\n\ts_barrier":::"memory");
  #undef DMA_K
  #undef DMA_V
  #undef CMASK
  #undef START
  #undef RESC
  #undef ROT
}
constexpr int ATTN_LDS_BYTES=LDS_BYTES;
#undef SBAR
#undef WAIT_BAR
}
#define LAS __attribute__((address_space(3)))
typedef unsigned short bf16;
typedef unsigned v4u __attribute__((ext_vector_type(4)));
typedef unsigned v2u __attribute__((ext_vector_type(2)));
typedef float f32x4 __attribute__((ext_vector_type(4)));
typedef short bf16x8 __attribute__((ext_vector_type(8)));
typedef float f32x2_g __attribute__((ext_vector_type(2)));
constexpr int NB = 8, SEQ = 2048, DM = 1024, FF = 4096, NH = 8, M = NB * SEQ, NWAVES = 8;
constexpr float EPS = 1e-6f;
constexpr size_t MiB = 1u << 20;
constexpr size_t WS_SS = 0, WS_BA = 4 * MiB, WS_CD = 5 * MiB, WS_WOA = 6 * MiB, WS_WIN = 8 * MiB, WS_XB = 16 * MiB, WS_P = 48 * MiB;
constexpr size_t WS_W = 144 * MiB, WS_QD = 176 * MiB, WS_KDT = 208 * MiB, WS_IN = 240 * MiB, WS_U = 16 * MiB;
constexpr size_t WS_W10 = 208 * MiB, WS_W20 = 216 * MiB, WS_WKVQ = 224 * MiB, WS_WOB = 230 * MiB, WS_W11 = 232 * MiB, WS_W21 = 240 * MiB;
constexpr size_t WS_OG = 48 * MiB, WS_H = 80 * MiB, WS_KVQ = 48 * MiB, WS_AO = 144 * MiB, WS_OD = 16 * MiB, WS_X3B = 48 * MiB, WS_END = 256 * MiB;
constexpr int LDS_BYTES = 147456;
constexpr size_t WS_ROPE = 8 * MiB;
constexpr size_t WS_BAR = 5 * MiB + 65536;
constexpr int LDS_BARST = 147440;

__device__ __forceinline__ float wave_sum(float v) {
#pragma unroll
    for (int o = 1; o < 64; o <<= 1) v += __shfl_xor(v, o);
    return v;
}
__device__ __forceinline__ unsigned pk2(float lo, float hi) { return pg8::pkbf(lo, hi); }
__device__ __forceinline__ float bflo(unsigned u) { return __uint_as_float(u << 16); }
__device__ __forceinline__ float bfhi(unsigned u) { return __uint_as_float(u & 0xffff0000u); }
__device__ __forceinline__ unsigned short f2bf1(float f) { return (unsigned short)(pk2(f, 0.f) & 0xffffu); }

struct Frame { LAS unsigned char* lds; int wave, vcu, G; };

__device__ __forceinline__ void transpose_item(const float* W, int ldw, int col_off, int K, int ncols, const float* nscale, bf16* WT, int row_off, int perm, LAS float* scr, int item, int lane) {
    const int nblk = ncols / 64, kb = item / nblk, nb = item % nblk, k0 = 64 * kb, n0 = 64 * nb, n4 = lane & 15, kr = lane >> 4;
    f32x4 v[16]; float sc[16];
#pragma unroll
    for (int i = 0; i < 16; ++i) { const int kk = 4 * i + kr; v[i] = __builtin_nontemporal_load((const f32x4*)(W + (size_t)(k0 + kk) * ldw + col_off + n0 + 4 * n4));     sc[i] = nscale ? nscale[k0 + kk] : 1.0f; }
#pragma unroll
    for (int i = 0; i < 16; ++i) { const int kk = 4 * i + kr; LAS float* d = scr + kk * 65 + 4 * n4; d[0] = v[i][0] * sc[i]; d[1] = v[i][1] * sc[i]; d[2] = v[i][2] * sc[i]; d[3] = v[i][3] * sc[i]; }
    asm volatile("s_waitcnt lgkmcnt(0)" ::: "memory");
#pragma unroll
    for (int j = 0; j < 8; ++j) { const int p = lane + 64 * j, n = p >> 3, c = p & 7; const LAS float* s = scr + (8 * c) * 65 + n;
        v4u o; o.x = pk2(s[0 * 65], s[1 * 65]); o.y = pk2(s[2 * 65], s[3 * 65]); o.z = pk2(s[4 * 65], s[5 * 65]); o.w = pk2(s[6 * 65], s[7 * 65]);
        const int cs_ = n0 + n, dr = perm ? ((cs_ & ~255) + 128 * ((cs_ >> 5) & 1) + 32 * ((cs_ >> 6) & 3) + (cs_ & 31)) : cs_;
        *(v4u*)(WT + (size_t)(row_off + dr) * K + k0 + 8 * c) = o; }
    asm volatile("s_waitcnt lgkmcnt(0)" ::: "memory");
}
struct TrJob { const float* W; int ldw, col_off, K, ncols; const float* nscale; bf16* WT; int row_off; int perm; };
template <int NJ> __device__ __forceinline__ void run_transposes(const Frame& F, const TrJob (&jobs)[NJ], int lane) {
    LAS float* scr = (LAS float*)(F.lds + F.wave * 17408);
    const int gw = F.vcu * NWAVES + F.wave, NGW = F.G * NWAVES;
    int total = 0;
#pragma unroll
    for (int j = 0; j < NJ; ++j) total += (jobs[j].K / 64) * (jobs[j].ncols / 64);
    for (int it = gw; it < total; it += NGW) {
        int r = it;
#pragma unroll
        for (int j = 0; j < NJ; ++j) { const int n = (jobs[j].K / 64) * (jobs[j].ncols / 64);
            if (r >= 0 && r < n) transpose_item(jobs[j].W, jobs[j].ldw, jobs[j].col_off, jobs[j].K, jobs[j].ncols, jobs[j].nscale, jobs[j].WT, jobs[j].row_off, jobs[j].perm, scr, r, lane);
            r -= n; }
    }
}

struct Args { const void* in[21]; float* out; unsigned char* ws; };

__device__ __forceinline__ bool xb_tid0() { return (__builtin_amdgcn_readfirstlane((int)threadIdx.x >> 6) == 0) && (fresh_lane() == 0); }
#define XB_TMO      128
#define XB_XCNT(j)  (256  + 64 * (j))
#define XB_XSUB(j)  (1280 + 64 * (j))
#define XB_XGEN(j)  (2304 + 64 * (j))
#define XB_TOP      3328
#define XB_TOPGEN   3392
#define XCD_BAR_WORDS 3456
#define XB_SPIN_CAP (1u << 18)

__device__ __forceinline__ unsigned xb_ld(unsigned* p)              { return __hip_atomic_load(p, __ATOMIC_RELAXED, __HIP_MEMORY_SCOPE_AGENT); }
__device__ __forceinline__ unsigned xb_add(unsigned* p, unsigned v) { return __hip_atomic_fetch_add(p, v, __ATOMIC_RELAXED, __HIP_MEMORY_SCOPE_AGENT); }
__device__ __forceinline__ unsigned xb_xcc_id() { return (unsigned)__builtin_amdgcn_s_getreg((3 << 11) | 20) & 0xFu; }
#define XB_SPIN(cond, bar) do { unsigned _sp = 0; while (cond) { __builtin_amdgcn_s_sleep(1); \
    if ((++_sp & 255u) == 0u) { if (xb_ld(&(bar)[XB_TMO])) break; if (_sp > XB_SPIN_CAP) { atomicAdd(&(bar)[XB_TMO], 1u); break; } } } } while (0)

struct XcdBarrier {
    unsigned* bar; unsigned x;
    volatile LAS unsigned* st;
};

__device__ __forceinline__ XcdBarrier xcd_barrier_post(unsigned* bar, volatile LAS unsigned* st) {
    XcdBarrier b; b.bar = bar; b.x = xb_xcc_id(); b.st = st;
    if (xb_tid0()) (void)xb_add(&bar[XB_XCNT(b.x)], 1u);
    return b;
}
__device__ __forceinline__ void xcd_barrier_complete(unsigned* bar, unsigned x, unsigned& nloc, unsigned& nx) {
    const unsigned G = gridDim.x * gridDim.y * gridDim.z;
    unsigned sum, cnt, mine, sp = 0u;
    for (;;) {
        sum = 0u; cnt = 0u; mine = 0u;
#pragma unroll
        for (unsigned j = 0; j < 16; ++j) { const unsigned c = xb_ld(&bar[XB_XCNT(j)]); sum += c; cnt += (c > 0u) ? 1u : 0u; mine = (j == x) ? c : mine; }
        if (sum == G) break;
        __builtin_amdgcn_s_sleep(1);
        if ((++sp & 255u) == 0u) { if (xb_ld(&bar[XB_TMO])) break; if (sp > XB_SPIN_CAP) { atomicAdd(&bar[XB_TMO], 1u); break; } }
    }
    nloc = mine > 0u ? mine : 1u; nx = cnt > 0u ? cnt : 1u;
}

__device__ __forceinline__ void xcd_barrier(const XcdBarrier& b) {
    asm volatile("s_waitcnt vmcnt(0)" ::: "memory");
    __syncthreads();
    if (xb_tid0()) {
        unsigned* bar = b.bar;
        __builtin_amdgcn_s_waitcnt(0);
        unsigned nloc = b.st[0], nx = b.st[1];
        if (nloc == 0u) { xcd_barrier_complete(bar, b.x, nloc, nx); b.st[0] = nloc; b.st[1] = nx; }
        const unsigned old = xb_add(&bar[XB_XSUB(b.x)], 1u);
        const unsigned gen = old / nloc;
        if (old + 1u == (gen + 1u) * nloc) {
            __builtin_amdgcn_fence(__ATOMIC_RELEASE, "agent");
            asm volatile("s_waitcnt vmcnt(0)" ::: "memory");
            const unsigned og = xb_add(&bar[XB_TOP], 1u);
            const unsigned tg = og / nx;
            if (og + 1u == (tg + 1u) * nx) xb_add(&bar[XB_TOPGEN], 1u);
            else XB_SPIN(xb_ld(&bar[XB_TOPGEN]) == tg, bar);
            __builtin_amdgcn_fence(__ATOMIC_ACQUIRE, "agent");
            xb_add(&bar[XB_XGEN(b.x)], 1u);
            asm volatile("s_waitcnt vmcnt(0)" ::: "memory");
        } else {
            XB_SPIN(xb_ld(&bar[XB_XGEN(b.x)]) == gen, bar);
            __builtin_amdgcn_fence(__ATOMIC_ACQUIRE, "agent");
            asm volatile("s_waitcnt vmcnt(0)" ::: "memory");
        }
    }
    __syncthreads();
}

__device__ __forceinline__ void phase_prologue(const Frame& F, const Args& A) {
    const float* x = (const float*)A.in[0]; const float* a_norm = (const float*)A.in[2]; const float* w_in = (const float*)A.in[3];
    unsigned char* ws = A.ws; const int lane = fresh_lane(), tid = F.wave * 64 + lane;
    LAS float* w16 = (LAS float*)F.lds;
    for (int e = tid; e < 16384; e += 512) { const int k = e >> 4, c = e & 15; w16[c * 1024 + k] = a_norm[k] * w_in[(size_t)k * 4112 + 4096 + c]; }
    __syncthreads();
    const int gw = F.vcu * NWAVES + F.wave, NGW = F.G * NWAVES;
    float* SS0 = (float*)(ws + WS_SS); float* BA = (float*)(ws + WS_BA); bf16* XB = (bf16*)(ws + WS_XB);
    f32x4 vnx[4];
    { const f32x4* xr = (const f32x4*)(x + (size_t)gw * DM) + lane;
#pragma unroll
      for (int j = 0; j < 4; ++j) vnx[j] = __builtin_nontemporal_load(xr + 64 * j); }
    for (int row = gw; row < M; row += NGW) {
        f32x4 v[4]; float s = 0.f;
#pragma unroll
        for (int j = 0; j < 4; ++j) v[j] = vnx[j];
        { const int nrow = (row + NGW < M) ? row + NGW : row; const f32x4* xr = (const f32x4*)(x + (size_t)nrow * DM) + lane;
#pragma unroll
          for (int j = 0; j < 4; ++j) vnx[j] = __builtin_nontemporal_load(xr + 64 * j); }
#pragma unroll
        for (int j = 0; j < 4; ++j) s += (v[j][0] * v[j][0] + v[j][1] * v[j][1]) + (v[j][2] * v[j][2] + v[j][3] * v[j][3]);
        s = wave_sum(s);
        const float rs = rsqrtf(s * (1.0f / DM) + EPS);
        v2u* o8 = (v2u*)(XB + (size_t)row * DM) + lane;
#pragma unroll
        for (int j = 0; j < 4; ++j) { v2u o; o.x = pk2(v[j][0], v[j][1]); o.y = pk2(v[j][2], v[j][3]); o8[64 * j] = o; }
        if (lane < 16) SS0[(size_t)row * 16 + lane] = s * (1.0f / 16.0f);
        float p[16];
#pragma unroll
        for (int c = 0; c < 16; ++c) { float a = 0.f;
#pragma unroll
            for (int j = 0; j < 4; ++j) { const f32x4 w = *(const LAS f32x4*)(w16 + c * 1024 + 4 * lane + 256 * j); a += (v[j][0] * w[0] + v[j][1] * w[1]) + (v[j][2] * w[2] + v[j][3] * w[3]); }
            p[c] = a; if ((c & 3) == 3) __builtin_amdgcn_sched_barrier(0); }
        float q8[8], r4[4], s2[2], t1;
        { const bool b = lane & 1;
#pragma unroll
          for (int i = 0; i < 8; ++i) { const float keep = b ? p[2 * i + 1] : p[2 * i], send = b ? p[2 * i] : p[2 * i + 1]; q8[i] = keep + __shfl_xor(send, 1); } }
        { const bool b = lane & 2;
#pragma unroll
          for (int i = 0; i < 4; ++i) { const float keep = b ? q8[2 * i + 1] : q8[2 * i], send = b ? q8[2 * i] : q8[2 * i + 1]; r4[i] = keep + __shfl_xor(send, 2); } }
        { const bool b = lane & 4;
#pragma unroll
          for (int i = 0; i < 2; ++i) { const float keep = b ? r4[2 * i + 1] : r4[2 * i], send = b ? r4[2 * i] : r4[2 * i + 1]; s2[i] = keep + __shfl_xor(send, 4); } }
        { const bool b = lane & 8; const float keep = b ? s2[1] : s2[0], send = b ? s2[0] : s2[1]; t1 = keep + __shfl_xor(send, 8); }
        t1 += __shfl_xor(t1, 16); t1 += __shfl_xor(t1, 32);
        if (lane < 16) BA[(size_t)row * 16 + lane] = t1 * rs;
    }
    __syncthreads();
    const TrJob jobs[2] = { { w_in, 4112, 0, DM, 4096, a_norm, (bf16*)(ws + WS_WIN), 0, 0 },
                            { (const float*)A.in[8], DM, 0, DM, DM, nullptr, (bf16*)(ws + WS_WOA), 0, 0 } };
    run_transposes<2>(F, jobs, lane);
}

__device__ __forceinline__ void phase_gdn_pre(const Frame& F, const Args& A) {
    unsigned char* ws = A.ws;
    const bf16* P = (const bf16*)(ws + WS_P); const float* BA = (const float*)(ws + WS_BA); float* CD = (float*)(ws + WS_CD);
    const float* conv_w = (const float*)A.in[4]; const float* a_log = (const float*)A.in[5]; const float* dt_bias = (const float*)A.in[6];
    bf16* Wg = (bf16*)(ws + WS_W); bf16* Ug = (bf16*)((unsigned char*)A.out + 32 * MiB);     bf16* QDg = (bf16*)(ws + WS_QD); bf16* KDTg = (bf16*)(ws + WS_KDT); bf16* INg = (bf16*)(ws + WS_IN);
    const int hw = F.wave >> 2, wv4 = F.wave & 3;
    LAS unsigned char* L = F.lds + hw * 71680;
    LAS unsigned char* Kn = L, *Qn = L + 17408, *KBGt = L + 34816, *VBt = L + 53248;
    LAS float* Lm = (LAS float*)Qn;
    LAS unsigned char* Tn = Kn;
    LAS float* sc_base = (LAS float*)(F.lds + 143360 + hw * 1024);
#define GDN_S1(unit_, dst_) do { const int ln_ = fresh_lane(); const int u_ = (unit_); const int h_ = (u_ >> 5) & 7, tok_ = (u_ >> 8) * SEQ + (u_ & 31) * 64 + ln_; \
        const float braw = BA[(size_t)tok_ * 16 + h_], araw = BA[(size_t)tok_ * 16 + 8 + h_]; \
        const float beta_ = 1.0f / (1.0f + expf(-braw)); const float xx = araw + dt_bias[h_]; \
        const float sp = fmaxf(xx, 0.f) + log1pf(expf(-fabsf(xx))); \
        float g = -expf(a_log[h_]) * sp; \
        _Pragma("unroll") for (int o = 1; o < 64; o <<= 1) { const float y = __shfl_up(g, o); if (ln_ >= o) g += y; } \
        (dst_)[ln_] = g; (dst_)[64 + ln_] = beta_; if (ln_ == 63) CD[u_] = expf(g); } while (0)
    if (wv4 == 0) GDN_S1(F.vcu * 2 + hw, sc_base);
    __syncthreads();
    for (int it = 0; it < 4; ++it) {
        const int lane = fresh_lane();
        const int r16 = lane & 15, q4 = lane >> 4, t = (wv4 << 6) | lane;
        const int unit = it * 512 + F.vcu * 2 + hw;
        int b = unit >> 8, h = (unit >> 5) & 7, ch = unit & 31; asm volatile("" : "+s"(b), "+s"(h), "+s"(ch));
        const int tok0 = b * SEQ + ch * 64;
        LAS float* sc = sc_base + (it & 1) * 128;
        {
            const int cg = lane & 15, rg = t >> 4, r0 = 4 * rg;
            float gcr[4], btr[4], egr[4], ekr[4]; const float glast = sc[63];
#pragma unroll
            for (int rr = 0; rr < 4; ++rr) { gcr[rr] = sc[r0 + rr]; btr[rr] = sc[64 + r0 + rr]; egr[rr] = __builtin_amdgcn_exp2f(1.4426950408889634f * gcr[rr]); ekr[rr] = __builtin_amdgcn_exp2f(1.4426950408889634f * (glast - gcr[rr])); }
            v4u xra[3][7];
#pragma unroll
            for (int seg = 0; seg < 3; ++seg)
#pragma unroll
                for (int li = 0; li < 7; ++li) { const int srow = ch * 64 + r0 + li - 3; const int crow = srow < 0 ? 0 : srow;
                    xra[seg][li] = __builtin_nontemporal_load((const v4u*)(P + (size_t)(b * SEQ + crow) * 3072 + seg * 1024 + h * 128 + cg * 8)); if (srow < 0) xra[seg][li] = (v4u){0u, 0u, 0u, 0u}; }
            f32x4 wvn[4][2];
#pragma unroll
            for (int j = 0; j < 4; ++j) { wvn[j][0] = *(const f32x4*)(conv_w + (size_t)j * 3072 + h * 128 + cg * 8); wvn[j][1] = *(const f32x4*)(conv_w + (size_t)j * 3072 + h * 128 + cg * 8 + 4); }
#pragma unroll
            for (int seg = 0; seg < 3; ++seg) {
                const int colbase = seg * 1024 + h * 128 + cg * 8;
                f32x4 wv[4][2];
#pragma unroll
                for (int j = 0; j < 4; ++j) { wv[j][0] = wvn[j][0]; wv[j][1] = wvn[j][1]; }
                if (seg < 2) {
#pragma unroll
                    for (int j = 0; j < 4; ++j) { wvn[j][0] = *(const f32x4*)(conv_w + (size_t)j * 3072 + colbase + 1024); wvn[j][1] = *(const f32x4*)(conv_w + (size_t)j * 3072 + colbase + 1024 + 4); } }
                float acc[4][8]; float ss[4];
#pragma unroll
                for (int rr = 0; rr < 4; ++rr) {
#pragma unroll
                    for (int e = 0; e < 8; ++e) acc[rr][e] = 0.f;
#pragma unroll
                    for (int j = 0; j < 4; ++j) { const v4u xv = xra[seg][rr + j];
                        acc[rr][0] += wv[j][0][0] * bflo(xv.x); acc[rr][1] += wv[j][0][1] * bfhi(xv.x); acc[rr][2] += wv[j][0][2] * bflo(xv.y); acc[rr][3] += wv[j][0][3] * bfhi(xv.y);
                        acc[rr][4] += wv[j][1][0] * bflo(xv.z); acc[rr][5] += wv[j][1][1] * bfhi(xv.z); acc[rr][6] += wv[j][1][2] * bflo(xv.w); acc[rr][7] += wv[j][1][3] * bfhi(xv.w); }
                    float s_ = 0.f;
#pragma unroll
                    for (int e = 0; e < 8; ++e) { const float v = acc[rr][e]; const float sv = v * __builtin_amdgcn_rcpf(1.0f + __builtin_amdgcn_exp2f(-1.4426950408889634f * v)); acc[rr][e] = sv; s_ += sv * sv; }
                    s_ += __shfl_xor(s_, 1); s_ += __shfl_xor(s_, 2); s_ += __shfl_xor(s_, 4); s_ += __shfl_xor(s_, 8);
                    ss[rr] = s_;
                }
                if (seg == 0) {
#pragma unroll
                    for (int rr = 0; rr < 4; ++rr) { const float s0 = rsqrtf(ss[rr] + EPS) * 0.08838834764831845f, eg = egr[rr]; v4u o, od;
                        const float a0 = acc[rr][0] * s0, a1 = acc[rr][1] * s0, a2 = acc[rr][2] * s0, a3 = acc[rr][3] * s0, a4 = acc[rr][4] * s0, a5 = acc[rr][5] * s0, a6 = acc[rr][6] * s0, a7 = acc[rr][7] * s0;
                        o.x = pk2(a0, a1); o.y = pk2(a2, a3); o.z = pk2(a4, a5); o.w = pk2(a6, a7);
                        od.x = pk2(a0 * eg, a1 * eg); od.y = pk2(a2 * eg, a3 * eg); od.z = pk2(a4 * eg, a5 * eg); od.w = pk2(a6 * eg, a7 * eg);
                        *(LAS v4u*)(Qn + (r0 + rr) * 272 + cg * 16) = o; *(v4u*)(QDg + (size_t)unit * 8192 + (r0 + rr) * 128 + cg * 8) = od; }
                } else if (seg == 1) {
                    float rn[4];
#pragma unroll
                    for (int rr = 0; rr < 4; ++rr) { rn[rr] = rsqrtf(ss[rr] + EPS); v4u o;
                        o.x = pk2(acc[rr][0] * rn[rr], acc[rr][1] * rn[rr]); o.y = pk2(acc[rr][2] * rn[rr], acc[rr][3] * rn[rr]); o.z = pk2(acc[rr][4] * rn[rr], acc[rr][5] * rn[rr]); o.w = pk2(acc[rr][6] * rn[rr], acc[rr][7] * rn[rr]);
                        *(LAS v4u*)(Kn + (r0 + rr) * 272 + cg * 16) = o; }
#pragma unroll
                    for (int e = 0; e < 8; ++e) { const int d = 8 * cg + e; const int so = ((((r0 >> 3) ^ (cg & 7))) << 4) + ((r0 & 4) << 1);
                        const float k0 = acc[0][e] * rn[0], k1 = acc[1][e] * rn[1], k2 = acc[2][e] * rn[2], k3 = acc[3][e] * rn[3];
                        v2u wb, wd; wb.x = pk2(k0 * btr[0] * egr[0], k1 * btr[1] * egr[1]); wb.y = pk2(k2 * btr[2] * egr[2], k3 * btr[3] * egr[3]);
                        wd.x = pk2(k0 * ekr[0], k1 * ekr[1]); wd.y = pk2(k2 * ekr[2], k3 * ekr[3]);
                        *(LAS v2u*)(KBGt + d * 144 + so) = wb; *(v2u*)(KDTg + (size_t)unit * 8192 + d * 64 + r0) = wd; }
                } else {
#pragma unroll
                    for (int e = 0; e < 8; ++e) { const int d = 8 * cg + e; const int so = ((((r0 >> 3) ^ (cg & 7))) << 4) + ((r0 & 4) << 1);
                        v2u wb; wb.x = pk2(acc[0][e] * btr[0], acc[1][e] * btr[1]); wb.y = pk2(acc[2][e] * btr[2], acc[3][e] * btr[3]);
                        *(LAS v2u*)(VBt + d * 144 + so) = wb; }
                }
            }
        }
        __syncthreads();
        {
            const int i = 16 * wv4 + r16; const float gci = sc[i];
#pragma unroll
            for (int jt = 0; jt < 4; ++jt) {
                f32x4 acc = {0.f, 0.f, 0.f, 0.f};
                if (jt <= wv4) {
#pragma unroll
                    for (int ks = 0; ks < 4; ++ks) { const bf16x8 a = *(const LAS bf16x8*)(Kn + (16 * jt + r16) * 272 + ks * 64 + q4 * 16); const bf16x8 bq = *(const LAS bf16x8*)(Qn + i * 272 + ks * 64 + q4 * 16);
                        acc = __builtin_amdgcn_mfma_f32_16x16x32_bf16(a, bq, acc, 0, 0, 0); }
                }
                float o[4];
#pragma unroll
                for (int e = 0; e < 4; ++e) { const int j = 16 * jt + 4 * q4 + e; o[e] = (j <= i) ? acc[e] * __builtin_amdgcn_exp2f(1.4426950408889634f * (gci - sc[j])) : 0.f; }
                v2u w; w.x = pk2(o[0], o[1]); w.y = pk2(o[2], o[3]);
                *(v2u*)(INg + (size_t)unit * 4096 + i * 64 + 16 * jt + 4 * q4) = w;
            }
        }
        __syncthreads();
        {
#pragma unroll
            for (int jt = 0; jt < 4; ++jt) {
                if (jt <= wv4) {
                    f32x4 acc = {0.f, 0.f, 0.f, 0.f};
#pragma unroll
                    for (int ks = 0; ks < 4; ++ks) { const bf16x8 a = *(const LAS bf16x8*)(Kn + (16 * wv4 + r16) * 272 + ks * 64 + q4 * 16); const bf16x8 bk = *(const LAS bf16x8*)(Kn + (16 * jt + r16) * 272 + ks * 64 + q4 * 16);
                        acc = __builtin_amdgcn_mfma_f32_16x16x32_bf16(a, bk, acc, 0, 0, 0); }
                    const int j = 16 * jt + r16; const float gcj = sc[j];
#pragma unroll
                    for (int e = 0; e < 4; ++e) { const int i = 16 * wv4 + 4 * q4 + e; Lm[i * 64 + j] = (j < i) ? sc[64 + i] * acc[e] * __builtin_amdgcn_exp2f(1.4426950408889634f * (sc[i] - gcj)) : 0.f; }
                }
            }
        }
        __syncthreads();
        if (wv4 == 1 && it < 3) GDN_S1((it + 1) * 512 + F.vcu * 2 + hw, sc_base + ((it + 1) & 1) * 128);
#ifndef NO_INV
        for (int rep5 = 0; rep5 < INV_REPS; ++rep5)
        if (wv4 == 0) {
            float tc[64]; int lane_o = lane; asm volatile("" : "+v"(lane_o));
            f32x4 lv[2][16];
#pragma unroll
            for (int i = 0; i < 64; ++i) {
                if (i + 1 < 64) {
#pragma unroll
                    for (int mq = 0; mq < (i + 1 + 3) / 4; ++mq) lv[(i + 1) & 1][mq] = *(const LAS f32x4*)(Lm + (i + 1) * 64 + 4 * mq);
                }
                __builtin_amdgcn_sched_barrier(0);
                float a0 = (lane_o == i) ? 1.f : 0.f, a1 = 0.f, a2 = 0.f, a3 = 0.f;
#pragma unroll
                for (int mq = 0; mq < (i + 3) / 4; ++mq) {
                    const f32x4 l4 = lv[i & 1][mq];
                    if (4 * mq + 0 < i) a0 -= l4[0] * tc[4 * mq + 0];
                    if (4 * mq + 1 < i) a1 -= l4[1] * tc[4 * mq + 1];
                    if (4 * mq + 2 < i) a2 -= l4[2] * tc[4 * mq + 2];
                    if (4 * mq + 3 < i) a3 -= l4[3] * tc[4 * mq + 3];
                }
                tc[i] = (a0 + a1) + (a2 + a3);
                asm volatile("" ::: "memory");
            }
#pragma unroll
            for (int i = 0; i < 64; ++i) *(LAS unsigned short*)(Tn + i * 144 + lane * 2) = f2bf1(tc[i]);
        }
#endif
        __syncthreads();
        {
#pragma unroll
            for (int which = 0; which < 2; ++which) {
                LAS unsigned char* Asrc = which ? VBt : KBGt; bf16* Og = (which ? Ug : Wg) + (size_t)unit * 8192;
#pragma unroll
                for (int dd = 0; dd < 2; ++dd) { const int dt = 2 * wv4 + dd;
                    const int dsw = (2 * dt + (r16 >> 3)) & 7;
                    const bf16x8 a0 = *(const LAS bf16x8*)(Asrc + (16 * dt + r16) * 144 + ((q4 ^ dsw) << 4)), a1 = *(const LAS bf16x8*)(Asrc + (16 * dt + r16) * 144 + (((4 + q4) ^ dsw) << 4));
#pragma unroll
                    for (int itl = 0; itl < 4; ++itl) {
                        const bf16x8 b0 = *(const LAS bf16x8*)(Tn + (16 * itl + r16) * 144 + q4 * 16), b1 = *(const LAS bf16x8*)(Tn + (16 * itl + r16) * 144 + 64 + q4 * 16);
                        f32x4 acc = {0.f, 0.f, 0.f, 0.f};
                        acc = __builtin_amdgcn_mfma_f32_16x16x32_bf16(a0, b0, acc, 0, 0, 0); acc = __builtin_amdgcn_mfma_f32_16x16x32_bf16(a1, b1, acc, 0, 0, 0);
                        v2u w; w.x = pk2(acc[0], acc[1]); w.y = pk2(acc[2], acc[3]);
                        *(v2u*)(Og + (16 * itl + r16) * 128 + 16 * dt + 4 * q4) = w; } }
            }
        }
        __syncthreads();
    }
}
__device__ __forceinline__ void phase_gdn_scan(const Frame& F, const Args& A) {
    unsigned char* ws = A.ws;
    const bf16* Wg = (const bf16*)(ws + WS_W); const bf16* Ug = (const bf16*)((unsigned char*)A.out + 32 * MiB); const bf16* QDg = (const bf16*)(ws + WS_QD); const bf16* KDTg = (const bf16*)(ws + WS_KDT); const bf16* INg = (const bf16*)(ws + WS_IN);
    const float* CD = (const float*)(ws + WS_CD);
    bf16* Oo = (bf16*)((unsigned char*)A.out + 32 * MiB);
    const int bh = F.vcu >> 2, sl = F.vcu & 3, b = bh >> 3, h = bh & 7, unit0 = bh * 32;
    const int lane = fresh_lane(), tid = F.wave * 64 + lane, r16 = lane & 15, q4 = lane >> 4, m = F.wave >> 1, n = F.wave & 1;
    constexpr int BUF = 62464, O_W = 0, O_QD = 17408, O_KDT = 34816, O_IN = 53248, O_S = 2 * BUF, O_VN = O_S + 8704, O_U = O_VN + 4608;
    LAS unsigned char* lds = F.lds;
    for (int e = tid; e < 8704 / 4; e += 512) ((LAS unsigned*)(lds + O_S))[e] = 0u;
    const int pW0 = tid, pW1 = tid + 512;
    const int lW0 = (pW0 >> 4) * 272 + (pW0 & 15) * 16, lW1 = (pW1 >> 4) * 272 + (pW1 & 15) * 16;
    const int lK0 = (pW0 >> 3) * 144 + (pW0 & 7) * 16, lK1 = (pW1 >> 3) * 144 + (pW1 & 7) * 16;
    const int lI = (tid >> 3) * 144 + (tid & 7) * 16;
    v4u rW[2][2], rQ[2][2], rK[2][2], rI[2], rU[2];
    const int urow = 16 * m + 4 * q4, ucol = 16 * n + r16;
    const float cdv = CD[unit0 + (lane & 31)];
#define SCAN_LOAD(u_, S_) do { const size_t ub = (size_t)(u_); \
        rW[S_][0] = *(const v4u*)(Wg + ub * 8192 + pW0 * 8); rW[S_][1] = *(const v4u*)(Wg + ub * 8192 + pW1 * 8); \
        rQ[S_][0] = *(const v4u*)(QDg + ub * 8192 + pW0 * 8); rQ[S_][1] = *(const v4u*)(QDg + ub * 8192 + pW1 * 8); \
        rK[S_][0] = *(const v4u*)(KDTg + ub * 8192 + pW0 * 8); rK[S_][1] = *(const v4u*)(KDTg + ub * 8192 + pW1 * 8); \
        rI[S_] = *(const v4u*)(INg + ub * 4096 + tid * 8); \
        rU[S_] = *(const v4u*)(Ug + ub * 8192 + ((tid & 255) >> 2) * 128 + sl * 32 + (tid & 3) * 8); } while (0)
#define SCAN_WRITE(bufo, S_) do { LAS unsigned char* bw = lds + (bufo); \
        *(LAS v4u*)(bw + O_W + lW0) = rW[S_][0]; *(LAS v4u*)(bw + O_W + lW1) = rW[S_][1]; *(LAS v4u*)(bw + O_QD + lW0) = rQ[S_][0]; *(LAS v4u*)(bw + O_QD + lW1) = rQ[S_][1]; \
        *(LAS v4u*)(bw + O_KDT + lK0) = rK[S_][0]; *(LAS v4u*)(bw + O_KDT + lK1) = rK[S_][1]; *(LAS v4u*)(bw + O_IN + lI) = rI[S_]; \
        *(LAS v4u*)(lds + O_U + ((tid & 255) >> 2) * 80 + (tid & 3) * 16) = rU[S_]; } while (0)
    SCAN_LOAD(unit0, 0);
    SCAN_WRITE(0, 0);
    SCAN_LOAD(unit0 + 1, 1);
    f32x4 Sa[2] = {{0.f, 0.f, 0.f, 0.f}, {0.f, 0.f, 0.f, 0.f}};
    __syncthreads();
#define SCAN_BODY(c, LS_, WS_) do { \
        const int bo = ((c) & 1) * BUF, bn = (((c) + 1) & 1) * BUF; \
        SCAN_LOAD(unit0 + ((c) + 2 < 32 ? (c) + 2 : 31), LS_);     \
        const float cd = __uint_as_float((unsigned)__builtin_amdgcn_readlane((int)__float_as_uint(cdv), (c))); \
        float ucur[4]; \
        _Pragma("unroll") for (int e = 0; e < 4; ++e) ucur[e] = __uint_as_float((unsigned)(*(const LAS unsigned short*)(lds + O_U + (urow + e) * 80 + ucol * 2)) << 16); \
        LAS unsigned char* bb = lds + bo; \
        f32x4 av = {0.f, 0.f, 0.f, 0.f}, ao = {0.f, 0.f, 0.f, 0.f}; \
        _Pragma("unroll") for (int ks = 0; ks < 4; ++ks) { \
            const bf16x8 sf = *(const LAS bf16x8*)(lds + O_S + (16 * n + r16) * 272 + ks * 64 + q4 * 16); \
            const bf16x8 af = *(const LAS bf16x8*)(bb + O_W + (16 * m + r16) * 272 + ks * 64 + q4 * 16); \
            const bf16x8 qf = *(const LAS bf16x8*)(bb + O_QD + (16 * m + r16) * 272 + ks * 64 + q4 * 16); \
            av = __builtin_amdgcn_mfma_f32_16x16x32_bf16(af, sf, av, 0, 0, 0); \
            ao = __builtin_amdgcn_mfma_f32_16x16x32_bf16(sf, qf, ao, 0, 0, 0); } \
        { v2u w; w.x = pk2(ucur[0] - av[0], ucur[1] - av[1]); w.y = pk2(ucur[2] - av[2], ucur[3] - av[3]); \
          *(LAS v2u*)(lds + O_VN + (16 * n + r16) * 144 + (16 * m + 4 * q4) * 2) = w; } \
        __syncthreads(); \
        Sa[0] = Sa[0] * cd; Sa[1] = Sa[1] * cd; \
        _Pragma("unroll") for (int ks = 0; ks < 2; ++ks) { \
            const bf16x8 vf = *(const LAS bf16x8*)(lds + O_VN + (16 * n + r16) * 144 + ks * 64 + q4 * 16); \
            const bf16x8 inf = *(const LAS bf16x8*)(bb + O_IN + (16 * m + r16) * 144 + ks * 64 + q4 * 16); \
            ao = __builtin_amdgcn_mfma_f32_16x16x32_bf16(vf, inf, ao, 0, 0, 0); \
            _Pragma("unroll") for (int tt = 0; tt < 2; ++tt) { const bf16x8 kf = *(const LAS bf16x8*)(bb + O_KDT + (16 * (2 * m + tt) + r16) * 144 + ks * 64 + q4 * 16); \
                Sa[tt] = __builtin_amdgcn_mfma_f32_16x16x32_bf16(kf, vf, Sa[tt], 0, 0, 0); } } \
        { v2u w; w.x = pk2(ao[0], ao[1]); w.y = pk2(ao[2], ao[3]); \
          *(v2u*)(Oo + (size_t)(unit0 + (c)) * 8192 + (16 * m + r16) * 128 + sl * 32 + 16 * n + 4 * q4) = w; }     \
        _Pragma("unroll") for (int tt = 0; tt < 2; ++tt) { v2u w; w.x = pk2(Sa[tt][0], Sa[tt][1]); w.y = pk2(Sa[tt][2], Sa[tt][3]); \
            *(LAS v2u*)(lds + O_S + (16 * n + r16) * 272 + (16 * (2 * m + tt) + 4 * q4) * 2) = w; } \
        SCAN_WRITE(bn, WS_); \
        __syncthreads(); } while (0)
#pragma unroll 1
    for (int c = 0; c < 32; c += 2) { SCAN_BODY(c, 0, 1); SCAN_BODY(c + 1, 1, 0); }
#undef SCAN_BODY
#undef SCAN_LOAD
#undef SCAN_WRITE
}

__device__ const float ROPE_FREQ[32] = {1.000000000e+00f, 7.498942614e-01f, 5.623413324e-01f, 4.216965139e-01f, 3.162277639e-01f, 2.371373773e-01f, 1.778279394e-01f, 1.333521307e-01f, 1.000000015e-01f, 7.498941571e-02f, 5.623413250e-02f, 4.216965288e-02f, 3.162277490e-02f, 2.371373773e-02f, 1.778279431e-02f, 1.333521493e-02f, 9.999999776e-03f, 7.498941850e-03f, 5.623413250e-03f, 4.216964822e-03f, 3.162277630e-03f, 2.371373586e-03f, 1.778279431e-03f, 1.333521446e-03f, 1.000000047e-03f, 7.498942432e-04f, 5.623413017e-04f, 4.216965172e-04f, 3.162277571e-04f, 2.371373703e-04f, 1.778279402e-04f, 1.333521504e-04f};
__device__ __forceinline__ void phase_gate(const Frame& F, const Args& A) {
    unsigned char* ws = A.ws;
    const bf16* Z = (const bf16*)A.out; const bf16* Oo = (const bf16*)((unsigned char*)A.out + 32 * MiB); bf16* OG = (bf16*)(ws + WS_OG);
    const float* out_norm = (const float*)A.in[7];
    const int gw = F.vcu * NWAVES + F.wave, NGW = F.G * NWAVES, lane = fresh_lane();
    float wn[8];
#pragma unroll
    for (int e = 0; e < 8; ++e) wn[e] = out_norm[((lane * 8) & 127) + e];
#define OADDR(row_, col_) ((size_t)((((row_) >> 11) * 8 + ((col_) >> 7)) * 32 + (((row_) >> 6) & 31)) * 8192 + ((row_) & 63) * 128 + ((col_) & 127))
    v4u on_[2], zn_[2];
#pragma unroll
    for (int j = 0; j < 2; ++j) { on_[j] = __builtin_nontemporal_load((const v4u*)(Oo + OADDR(gw, lane * 8 + 512 * j))); zn_[j] = __builtin_nontemporal_load((const v4u*)(Z + (size_t)gw * DM + lane * 8 + 512 * j)); }
    for (int row = gw; row < M; row += NGW) {
        v4u oc_[2], zc_[2];
#pragma unroll
        for (int j = 0; j < 2; ++j) { oc_[j] = on_[j]; zc_[j] = zn_[j]; }
        { const int nrow = (row + NGW < M) ? row + NGW : row;
#pragma unroll
          for (int j = 0; j < 2; ++j) { on_[j] = __builtin_nontemporal_load((const v4u*)(Oo + OADDR(nrow, lane * 8 + 512 * j))); zn_[j] = __builtin_nontemporal_load((const v4u*)(Z + (size_t)nrow * DM + lane * 8 + 512 * j)); } }
#pragma unroll
        for (int j = 0; j < 2; ++j) { const int col = lane * 8 + 512 * j;
            const v4u o8 = oc_[j], z8 = zc_[j];
            float o[8] = {bflo(o8.x), bfhi(o8.x), bflo(o8.y), bfhi(o8.y), bflo(o8.z), bfhi(o8.z), bflo(o8.w), bfhi(o8.w)};
            float z[8] = {bflo(z8.x), bfhi(z8.x), bflo(z8.y), bfhi(z8.y), bflo(z8.z), bfhi(z8.z), bflo(z8.w), bfhi(z8.w)};
            float ss = 0.f;
#pragma unroll
            for (int e = 0; e < 8; ++e) ss += o[e] * o[e];
            ss += __shfl_xor(ss, 1); ss += __shfl_xor(ss, 2); ss += __shfl_xor(ss, 4); ss += __shfl_xor(ss, 8);
            const float rs = rsqrtf(ss * (1.0f / 128.0f) + EPS);
            float y[8];
#pragma unroll
            for (int e = 0; e < 8; ++e) y[e] = o[e] * rs * wn[e] * (z[e] * __builtin_amdgcn_rcpf(1.0f + __builtin_amdgcn_exp2f(-1.4426950408889634f * z[e])));
            v4u w; w.x = pk2(y[0], y[1]); w.y = pk2(y[2], y[3]); w.z = pk2(y[4], y[5]); w.w = pk2(y[6], y[7]);
            *(v4u*)(OG + (size_t)row * DM + col) = w; }
    }
    {
      float* RT = (float*)(ws + WS_ROPE); const int* positions = (const int*)A.in[1]; const float fq_ = ROPE_FREQ[lane & 31];
      for (int row = 2 * gw + (lane >> 5); row < M; row += 2 * NGW) { const float ang = (float)positions[row] * fq_;
          double rv = (double)ang * 0.15915494309189535; rv -= __builtin_rint(rv);
          f32x2_g o; o.x = __builtin_amdgcn_cosf((float)rv); o.y = __builtin_amdgcn_sinf((float)rv); *(f32x2_g*)(RT + (size_t)row * 64 + 2 * (lane & 31)) = o; } }
    const float* mlp_norm = (const float*)A.in[18]; const float* w1 = (const float*)A.in[19]; const float* w2 = (const float*)A.in[20];
    const TrJob jobs[8] = { { w1, FF, 0, DM, FF, mlp_norm, (bf16*)(ws + WS_W10), 0, 0 },
                            { w2, DM, 0, FF, DM, nullptr, (bf16*)(ws + WS_W20), 0, 0 },
                            { (const float*)A.in[10], 2048, 0, DM, 1024, (const float*)A.in[9], (bf16*)(ws + WS_WKVQ), 0, 1 },
                            { (const float*)A.in[10], 2048, 1024, DM, 1024, (const float*)A.in[9], (bf16*)(ws + WS_WKVQ), 1024, 0 },
                            { (const float*)A.in[13], DM, 0, DM, DM, (const float*)A.in[12], (bf16*)(ws + WS_WKVQ), 2048, 1 },
                            { (const float*)A.in[17], DM, 0, DM, DM, nullptr, (bf16*)(ws + WS_WOB), 0, 0 },
                            { w1 + (size_t)DM * FF, FF, 0, DM, FF, mlp_norm + DM, (bf16*)(ws + WS_W11), 0, 0 },
                            { w2 + (size_t)FF * DM, DM, 0, FF, DM, nullptr, (bf16*)(ws + WS_W21), 0, 0 } };
    run_transposes<8>(F, jobs, lane);
}

__device__ __forceinline__ void phase_normrope(const Frame& F, const Args& A) {
    bf16* KVQ = (bf16*)(A.ws + WS_KVQ); const int* positions = (const int*)A.in[1];
    const float* k_norm = (const float*)A.in[11]; const float* q_norm = (const float*)A.in[14];
    const int gw = F.vcu * NWAVES + F.wave, NGW = F.G * NWAVES, lane = fresh_lane(), dq = lane & 15, gs = lane >> 4, d0 = 2 * dq;
    const float f0 = ROPE_FREQ[d0], f1 = ROPE_FREQ[d0 + 1];
    const float kw0 = k_norm[d0], kw1 = k_norm[d0 + 1], kw2 = k_norm[32 + d0], kw3 = k_norm[33 + d0];
    const float qw0 = q_norm[d0], qw1 = q_norm[d0 + 1], qw2 = q_norm[32 + d0], qw3 = q_norm[33 + d0];
    constexpr float C2 = 0.125f * 1.4426950408889634f;
    for (int row = gw; row < M; row += NGW) {
        const float pos = (float)positions[row];
        const float a0 = pos * f0, a1 = pos * f1;
        double r0 = (double)a0 * 0.15915494309189535, r1 = (double)a1 * 0.15915494309189535;
        r0 -= __builtin_rint(r0); r1 -= __builtin_rint(r1);
        const float c0 = __builtin_amdgcn_cosf((float)r0), s0 = __builtin_amdgcn_sinf((float)r0), c1 = __builtin_amdgcn_cosf((float)r1), s1 = __builtin_amdgcn_sinf((float)r1);
        unsigned u1[2][4], u2[2][4];
#pragma unroll
        for (int part = 0; part < 2; ++part)
#pragma unroll
            for (int it = 0; it < 4; ++it) { const bf16* base = KVQ + (size_t)row * 3072 + part * 2048 + (4 * it + gs) * 64 + d0; u1[part][it] = *(const unsigned*)base; u2[part][it] = *(const unsigned*)(base + 32); }
#pragma unroll
        for (int part = 0; part < 2; ++part) {
            bf16* base = KVQ + (size_t)row * 3072 + part * 2048;
            const float w0 = part ? qw0 : kw0, w1 = part ? qw1 : kw1, w2 = part ? qw2 : kw2, w3 = part ? qw3 : kw3, osc = part ? C2 : 1.0f;
#pragma unroll
            for (int it = 0; it < 4; ++it) { const int g = 4 * it + gs;
                unsigned* p1 = (unsigned*)(base + g * 64 + d0); unsigned* p2 = (unsigned*)(base + g * 64 + 32 + d0);
                const unsigned a1 = u1[part][it], a2 = u2[part][it];
                const float t10 = bflo(a1), t11 = bfhi(a1), t20 = bflo(a2), t21 = bfhi(a2);
                float ss = (t10 * t10 + t11 * t11) + (t20 * t20 + t21 * t21);
                ss += __shfl_xor(ss, 1); ss += __shfl_xor(ss, 2); ss += __shfl_xor(ss, 4); ss += __shfl_xor(ss, 8);
                const float rs = rsqrtf(ss * (1.0f / 64.0f) + EPS) * osc;
                const float y10 = t10 * rs * w0, y11 = t11 * rs * w1, y20 = t20 * rs * w2, y21 = t21 * rs * w3;
                *p1 = pk2(y10 * c0 - y20 * s0, y11 * c1 - y21 * s1); *p2 = pk2(y20 * c0 + y10 * s0, y21 * c1 + y11 * s1); }
        }
    }
}

__device__ __forceinline__ void phase_combine(const Frame& F, const Args& A) {
    const bf16* AO = (const bf16*)(A.ws + WS_AO); bf16* OD = (bf16*)(A.ws + WS_OD);
    const float* lp = (const float*)A.in[15]; const float* sub_norm = (const float*)A.in[16];
    const int gw = F.vcu * NWAVES + F.wave, NGW = F.G * NWAVES, lane = fresh_lane();
    constexpr float LAM_INIT = 0.35550906759096934f;
    const float s0 = wave_sum(lp[lane] * lp[64 + lane]), s1 = wave_sum(lp[128 + lane] * lp[192 + lane]);
    const float lam = expf(s0) - expf(s1) + LAM_INIT;
    float wn[8];
#pragma unroll
    for (int e = 0; e < 8; ++e) wn[e] = sub_norm[((lane * 8) & 127) + e] * (1.0f - LAM_INIT);
    v4u an_[2], bn_[2];
#pragma unroll
    for (int j = 0; j < 2; ++j) { const int col = lane * 8 + 512 * j, hh = col >> 7, d = col & 127; an_[j] = *(const v4u*)(AO + (size_t)gw * 2048 + hh * 256 + d); bn_[j] = *(const v4u*)(AO + (size_t)gw * 2048 + hh * 256 + 128 + d); }
    for (int row = gw; row < M; row += NGW) {
        v4u ac_[2], bc_[2];
#pragma unroll
        for (int j = 0; j < 2; ++j) { ac_[j] = an_[j]; bc_[j] = bn_[j]; }
        { const int nrow = (row + NGW < M) ? row + NGW : row;
#pragma unroll
          for (int j = 0; j < 2; ++j) { const int col = lane * 8 + 512 * j, hh = col >> 7, d = col & 127; an_[j] = *(const v4u*)(AO + (size_t)nrow * 2048 + hh * 256 + d); bn_[j] = *(const v4u*)(AO + (size_t)nrow * 2048 + hh * 256 + 128 + d); } }
#pragma unroll
        for (int j = 0; j < 2; ++j) { const int col = lane * 8 + 512 * j;
            const v4u a8 = ac_[j], b8 = bc_[j];
            float x[8] = {bflo(a8.x) - lam * bflo(b8.x), bfhi(a8.x) - lam * bfhi(b8.x), bflo(a8.y) - lam * bflo(b8.y), bfhi(a8.y) - lam * bfhi(b8.y),
                          bflo(a8.z) - lam * bflo(b8.z), bfhi(a8.z) - lam * bfhi(b8.z), bflo(a8.w) - lam * bflo(b8.w), bfhi(a8.w) - lam * bfhi(b8.w)};
            float ss = 0.f;
#pragma unroll
            for (int e = 0; e < 8; ++e) ss += x[e] * x[e];
            ss += __shfl_xor(ss, 1); ss += __shfl_xor(ss, 2); ss += __shfl_xor(ss, 4); ss += __shfl_xor(ss, 8);
            const float rs = rsqrtf(ss * (1.0f / 128.0f) + EPS);
            v4u w; w.x = pk2(x[0] * rs * wn[0], x[1] * rs * wn[1]); w.y = pk2(x[2] * rs * wn[2], x[3] * rs * wn[3]); w.z = pk2(x[4] * rs * wn[4], x[5] * rs * wn[5]); w.w = pk2(x[6] * rs * wn[6], x[7] * rs * wn[7]);
            *(v4u*)(OD + (size_t)row * DM + col) = w; }
    }
}

constexpr int LDS_RSB = 131072;
__device__ __forceinline__ void prep_rs(const Frame& F, const float* ss, const pg8::StaticOrder& S, const float* kn = nullptr, const float* qn = nullptr) {
    const int lane = fresh_lane(), tid = F.wave * 64 + lane; LAS float* rsb = (LAS float*)(F.lds + LDS_RSB);
    if (kn && tid >= 256 && tid < 384) rsb[1024 + tid - 256] = (tid < 320) ? kn[tid - 256] : qn[tid - 320];
    if (tid < 256) {
#pragma unroll
        for (int i = 0; i < 4; ++i) { pg8::Unit u; if (S.next(i, u)) rsb[i * 256 + tid] = pg8::row_rs(ss, u.pm * 256 + tid); }
    }
    __syncthreads();
}
#ifndef PH_MASK
#define PH_MASK 0xffffffffu
#endif
#define PH(k) ((PH_MASK >> (k)) & 1u)
#ifndef DUP_MASK
#define DUP_MASK 0u
#endif
#ifndef SYNC_EXTRA
#define SYNC_EXTRA 0
#endif
#define GSYNC(k) do { if ((k) == 0) grid.sync(); else xcd_barrier(bar); } while (0)
#define RUN(k, ...) for (int rep_ = 0; rep_ < 1 + (int)((DUP_MASK >> (k)) & 1u); ++rep_) { if (PH(k)) { __VA_ARGS__; } if ((k) != 14 || rep_ == 0 && ((DUP_MASK >> 14) & 1u)) GSYNC(k); }
__global__ void __launch_bounds__(NWAVES * 64, 2) yoco_fwd(Args args) {
    extern __shared__ __attribute__((aligned(16))) unsigned char lds_raw[];
    cg::grid_group grid = cg::this_grid();
    Frame F; F.lds = (LAS unsigned char*)lds_raw; F.wave = __builtin_amdgcn_readfirstlane((int)threadIdx.x >> 6);
    F.G = gridDim.x; { const int bx = blockIdx.x; F.vcu = (F.G % 8 == 0) ? (bx % 8) * (F.G / 8) + bx / 8 : bx; }
    unsigned char* ws = args.ws;
    float* SS0 = (float*)(ws + WS_SS); float* SS1 = SS0 + (size_t)M * 16; float* SS2 = SS1 + (size_t)M * 16; float* SS3 = SS2 + (size_t)M * 16;
    bf16* XB = (bf16*)(ws + WS_XB);
    float* out = args.out;
    { volatile LAS unsigned* st = (volatile LAS unsigned*)(F.lds + LDS_BARST); if (xb_tid0()) { st[0] = 0u; st[1] = 0u; } }
    __syncthreads();
    XcdBarrier bar = xcd_barrier_post((unsigned*)(ws + WS_BAR), (volatile LAS unsigned*)(F.lds + LDS_BARST));
    for (int e_ = 0; e_ < SYNC_EXTRA; ++e_) xcd_barrier(bar);
    RUN(0, phase_prologue(F, args);)
    RUN(1, { pg8::Gemm g{XB, (const bf16*)(ws + WS_WIN), M, 4096, DM}; pg8::StaticOrder S; S.init(M, 4096, F.G, (int)blockIdx.x);
      prep_rs(F, SS0, S);
      pg8::EpiScaleBf16<0> E{(bf16*)(ws + WS_P), 3072, (bf16*)out, 1024, 12, (const LAS float*)(F.lds + LDS_RSB)};
      pg8::gemm_phase<pg8::EpiScaleBf16<0>, pg8::StaticOrder, true, true>(F.lds, g, S, E, F.wave); })
    RUN(2, phase_gdn_pre(F, args);)
    RUN(3, phase_gdn_scan(F, args);)
    RUN(4, phase_gate(F, args);)
    RUN(5, { pg8::Gemm g{(const bf16*)(ws + WS_OG), (const bf16*)(ws + WS_WOA), M, DM, DM}; pg8::StaticOrder S; S.init(M, DM, F.G, (int)blockIdx.x);
      pg8::EpiResid<true, false, true> E{XB, nullptr, XB, SS1};
      pg8::gemm_phase<pg8::EpiResid<true, false, true>, pg8::StaticOrder, true, true>(F.lds, g, S, E, F.wave); })
    RUN(6, { pg8::Gemm g{XB, (const bf16*)(ws + WS_W10), M, FF, DM}; pg8::StaticOrder S; S.init(M, FF, F.G, (int)blockIdx.x);
      prep_rs(F, SS1, S);
      pg8::EpiScaleBf16<1> E{(bf16*)(ws + WS_H), FF, nullptr, 0, 1 << 30, (const LAS float*)(F.lds + LDS_RSB)};
      pg8::gemm_phase<pg8::EpiScaleBf16<1>, pg8::StaticOrder, true, true>(F.lds, g, S, E, F.wave); })
    RUN(7, { pg8::Gemm g{(const bf16*)(ws + WS_H), (const bf16*)(ws + WS_W20), M, DM, FF}; pg8::StaticOrder S; S.init(M, DM, F.G, (int)blockIdx.x);
      pg8::EpiResid<true, false, true> E{XB, nullptr, XB, SS2};
      pg8::gemm_phase<pg8::EpiResid<true, false, true>, pg8::StaticOrder, true, true>(F.lds, g, S, E, F.wave); })
    RUN(8, { pg8::Gemm g{XB, (const bf16*)(ws + WS_WKVQ), M, 3072, DM}; pg8::StaticOrder S; S.init(M, 3072, F.G, (int)blockIdx.x);
      prep_rs(F, SS2, S, (const float*)args.in[11], (const float*)args.in[14]);
      pg8::EpiKVQ E{(bf16*)(ws + WS_KVQ), (const LAS float*)(F.lds + LDS_RSB), (const float*)(ws + WS_ROPE), (const float*)args.in[11], (const float*)args.in[14]};
      pg8::gemm_phase<pg8::EpiKVQ, pg8::StaticOrder, true, true>(F.lds, g, S, E, F.wave); })
    RUN(10, { const int bh = F.vcu >> 2, sp = F.vcu & 3, b = bh >> 3, h = bh & 7;
      const attn_body::bf16* KVQ = (const attn_body::bf16*)(ws + WS_KVQ); attn_body::bf16* OD = (attn_body::bf16*)out + h * 128;
      constexpr float LAM_INIT = 0.35550906759096934f;
      const float* lp = (const float*)args.in[15]; const float* subn = (const float*)args.in[16];
      float lam; { const int ln = fresh_lane(); const float s0 = wave_sum(lp[ln] * lp[64 + ln]), s1 = wave_sum(lp[128 + ln] * lp[192 + ln]); lam = expf(s0) - expf(s1) + LAM_INIT; }
      LAS float* subw = (LAS float*)(F.lds + 120 * 1024);
      { const int ln = fresh_lane(); if (F.wave == 0) { subw[ln] = subn[ln] * (1.0f - LAM_INIT); subw[64 + ln] = subn[64 + ln] * (1.0f - LAM_INIT); } }
      __syncthreads();
      for (int qi = 0; qi < 2; ++qi) { const int qb = qi ? sp : 7 - sp;
          for (int su = 0; su < 4; ++su) { const int mm = su >> 1, hf = su & 1;
              attn_body::attn_unit<8>(b, F.wave, qb, KVQ + 2048 + (2 * h + mm) * 64, KVQ + (2 * h + mm) * 64, KVQ + 1024 + h * 128 + hf * 64, OD, (char*)lds_raw, mm, hf, lam, su == 3, (const float*)(lds_raw + 120 * 1024)); } } })
    RUN(12, { pg8::Gemm g{(const bf16*)out, (const bf16*)(ws + WS_WOB), M, DM, DM}; pg8::StaticOrder S; S.init(M, DM, F.G, (int)blockIdx.x);
      pg8::EpiResid<true, false, true> E{XB, nullptr, (bf16*)(ws + WS_X3B), SS3};
      pg8::gemm_phase<pg8::EpiResid<true, false, true>, pg8::StaticOrder, true, true>(F.lds, g, S, E, F.wave); })
    RUN(13, { pg8::Gemm g{(const bf16*)(ws + WS_X3B), (const bf16*)(ws + WS_W11), M, FF, DM}; pg8::StaticOrder S; S.init(M, FF, F.G, (int)blockIdx.x);
      prep_rs(F, SS3, S);
      pg8::EpiScaleBf16<1> E{(bf16*)(ws + WS_H), FF, nullptr, 0, 1 << 30, (const LAS float*)(F.lds + LDS_RSB)};
      pg8::gemm_phase<pg8::EpiScaleBf16<1>, pg8::StaticOrder, true, true>(F.lds, g, S, E, F.wave); })
    RUN(14, { pg8::Gemm g{(const bf16*)(ws + WS_H), (const bf16*)(ws + WS_W21), M, DM, FF}; pg8::StaticOrder S; S.init(M, DM, F.G, (int)blockIdx.x);
      pg8::EpiResid<true, true, false> E{(const bf16*)(ws + WS_X3B), out, nullptr, nullptr};
      pg8::gemm_phase<pg8::EpiResid<true, true, false>, pg8::StaticOrder, true, true>(F.lds, g, S, E, F.wave); })
}

extern "C" void kernel_launch(void* const* d_in, const int* in_sizes, int n_in, void* d_out, int out_size, void* d_ws, size_t ws_size, hipStream_t stream) {
    static int ready = 0;
    if (ready == 0) {
        if (n_in != 21 || out_size != M * DM || ws_size < WS_END) { fprintf(stderr, "kernel_launch: unexpected shapes (n_in %d out %d ws %zu)\n", n_in, out_size, ws_size); ready = -1; return; }
        if (hipFuncSetAttribute((const void*)yoco_fwd, hipFuncAttributeMaxDynamicSharedMemorySize, LDS_BYTES) != hipSuccess) { fprintf(stderr, "kernel_launch: hipFuncSetAttribute failed\n"); ready = -1; return; }
        int per_cu = 0; (void)hipOccupancyMaxActiveBlocksPerMultiprocessor(&per_cu, (const void*)yoco_fwd, NWAVES * 64, LDS_BYTES); (void)hipGetLastError();
        if (per_cu < 1) fprintf(stderr, "kernel_launch: occupancy query reports %d blocks per CU\n", per_cu);
        ready = 1;
    }
    if (ready < 0) return;
    Args a{};
    for (int i = 0; i < 21; ++i) a.in[i] = d_in[i];
    a.out = (float*)d_out; a.ws = (unsigned char*)d_ws;
    if (hipMemsetAsync((char*)d_ws + WS_BAR, 0, 16384, stream) != hipSuccess) { fprintf(stderr, "kernel_launch: memset of the barrier words failed\n"); return; }
    void* kargs[] = { &a };
    hipError_t e = hipLaunchCooperativeKernel((const void*)yoco_fwd, dim3(256), dim3(NWAVES * 64), kargs, LDS_BYTES, stream);
    if (e != hipSuccess) fprintf(stderr, "cooperative launch failed: %s\n", hipGetErrorString(e));
}
```

```cpp
#include <hip/hip_runtime.h>
#include <hip/hip_cooperative_groups.h>
#include <cstdio>
#include <cstdint>
namespace cg = cooperative_groups;
#ifndef INV_REPS
#define INV_REPS 1
#endif
__device__ __forceinline__ int fresh_lane() { int l; asm volatile("v_mbcnt_lo_u32_b32 %0, -1, 0\n\tv_mbcnt_hi_u32_b32 %0, -1, %0" : "=v"(l)); return l; }
namespace pg8 {
#define PG8_LAS __attribute__((address_space(3)))
typedef unsigned short bf16_t;
typedef short bf16x8 __attribute__((ext_vector_type(8)));
typedef float f32x4 __attribute__((ext_vector_type(4)));
typedef unsigned u32x4 __attribute__((ext_vector_type(4)));
constexpr int BM = 256, BK = 64, HALF = 128, HTB = HALF * BK * 2  , STAGE_BYTES = 8 * HTB, NXCD = 8, WGM = 8;

__host__ __device__ __forceinline__ int lds_byte(int r, int c) { const int st = (r >> 4) * 2 + (c >> 5), rr = r & 15, cc = c & 31, ob = rr * 64 + cc * 2; return st * 1024 + (ob ^ (((ob >> 9) & 1) << 5)); }
__host__ __device__ __forceinline__ void stage_rc(int b, int& R, int& C) { const int st = b / 1024, sb = b % 1024, swz = sb ^ (((sb >> 9) & 1) << 5); R = (st >> 1) * 16 + swz / 64; C = (st & 1) * 32 + (swz % 64) / 2; }
__host__ __device__ __forceinline__ int perm32(int rho) { const int n = rho >> 4, i = rho & 15; return 8 * (i >> 2) + 4 * n + (i & 3); }

struct Unit { int pm, pn; };
struct Gemm { const bf16_t* A; const bf16_t* Bt; int M, N, K; };

struct StaticOrder {
    int nM, nN, nwg, G, c;
    __host__ __device__ void init(int M, int N, int G_, int c_) { nM = M / BM; nN = N / BM; nwg = nM * nN; G = G_; c = c_; }
    __host__ __device__ bool next(int i, Unit& u) const {
        const long L = (long)i * G + c; if (L >= nwg) return false;
        int wgid = (int)L; { const int q = nwg / NXCD, r = nwg % NXCD, xcd = wgid % NXCD, off = wgid / NXCD; wgid = (xcd < r ? xcd * (q + 1) : r * (q + 1) + (xcd - r) * q) + off; }
        const int nig = WGM * nN, gid = wgid / nig, fm = gid * WGM, gsz = (nM - fm) < WGM ? (nM - fm) : WGM;
        u.pm = fm + ((wgid % nig) % gsz); u.pn = (wgid % nig) / gsz; return true;
    }
    __device__ __forceinline__ void a_ready(const Unit&) const {}
    __device__ __forceinline__ void done(const Unit&) const {}
};
__device__ __forceinline__ unsigned cvt_pk_bf16(float lo, float hi) { unsigned r; asm volatile("v_cvt_pk_bf16_f32 %0, %1, %2" : "=v"(r) : "v"(lo), "v"(hi)); return r; }
typedef float f32x2 __attribute__((ext_vector_type(2)));
typedef __bf16 bf16x2_tt __attribute__((ext_vector_type(2)));
typedef float f32x2_tt __attribute__((ext_vector_type(2)));
__device__ __forceinline__ unsigned pkbf(float lo, float hi) { f32x2_tt v = {lo, hi}; bf16x2_tt b = __builtin_convertvector(v, bf16x2_tt); return __builtin_bit_cast(unsigned, b); }
__device__ __forceinline__ float row_rs(const float* ss, int row) {
    const f32x4* p = (const f32x4*)(ss + (size_t)row * 16);
    const f32x4 a = p[0], b = p[1], c = p[2], d = p[3];
    const float s = ((a[0] + a[1]) + (a[2] + a[3])) + ((b[0] + b[1]) + (b[2] + b[3])) + ((c[0] + c[1]) + (c[2] + c[3])) + ((d[0] + d[1]) + (d[2] + d[3]));
    return rsqrtf(s * (1.0f / 1024.0f) + 1e-6f);
}
template <int ACT> struct EpiScaleBf16 {
    static constexpr bool PERM = true, AFTER_DRAIN = false;
    bf16_t* O; int ldc; bf16_t* O2; int ldc2; int split_tile; const PG8_LAS float* rsb;
    __device__ __forceinline__ void operator()(const f32x4 (&acc)[2][2][4][2], const Unit& u, int wr, int wc, int fr, int fq, int ui) const {
        const int row0 = u.pm * BM + wr * 64 + fr; bf16_t* base = O; int ld = ldc; int colt = u.pn * BM;
        if (u.pn >= split_tile) { base = O2; ld = ldc2; colt -= split_tile * BM; }
        const int col0 = colt + wc * 32 + 8 * fq;
#pragma unroll
        for (int ai = 0; ai < 2; ++ai)
#pragma unroll
            for (int m = 0; m < 4; ++m) { const int row = row0 + ai * HALF + m * 16; const float rs = rsb[ui * 256 + wr * 64 + fr + ai * HALF + m * 16]; bf16_t* rowp = base + (size_t)row * ld + col0;
#pragma unroll
                for (int bj = 0; bj < 2; ++bj) { f32x4 v0 = acc[ai][bj][m][0] * rs, v1 = acc[ai][bj][m][1] * rs;
                    if (ACT == 1) {
#pragma unroll
                        for (int e = 0; e < 4; ++e) { const float a = fmaxf(v0[e], 0.f), b = fmaxf(v1[e], 0.f); v0[e] = a * a; v1[e] = b * b; } }
                    u32x4 w; w.x = pkbf(v0[0], v0[1]); w.y = pkbf(v0[2], v0[3]); w.z = pkbf(v1[0], v1[1]); w.w = pkbf(v1[2], v1[3]);
                    *(u32x4*)(rowp + bj * HALF) = w; } }
    }
};
__device__ __forceinline__ float bfl_(unsigned u) { return __uint_as_float(u << 16); }
__device__ __forceinline__ float bfh_(unsigned u) { return __uint_as_float(u & 0xffff0000u); }
template <bool BASE_BF16, bool OUT_F32, bool WITH_B> struct EpiResid {
    static constexpr bool PERM = true, AFTER_DRAIN = false;
    const void* base; float* out; bf16_t* xb; float* ssn;
    __device__ __forceinline__ void operator()(const f32x4 (&acc)[2][2][4][2], const Unit& u, int wr, int wc, int fr, int fq, int) const {
        const int row0 = u.pm * BM + wr * 64 + fr; const int col0 = u.pn * BM + wc * 32 + 8 * fq;
#pragma unroll
        for (int ai = 0; ai < 2; ++ai)
#pragma unroll
            for (int m = 0; m < 4; ++m) { const int row = row0 + ai * HALF + m * 16; const size_t off = (size_t)row * 1024 + col0; float s = 0.f;
#pragma unroll
                for (int bj = 0; bj < 2; ++bj) { f32x4 b0, b1;
                    if (BASE_BF16) { const u32x4 bb = *(const u32x4*)((const bf16_t*)base + off + bj * HALF); b0 = (f32x4){bfl_(bb.x), bfh_(bb.x), bfl_(bb.y), bfh_(bb.y)}; b1 = (f32x4){bfl_(bb.z), bfh_(bb.z), bfl_(bb.w), bfh_(bb.w)}; }
                    else { b0 = __builtin_nontemporal_load((const f32x4*)((const float*)base + off + bj * HALF)); b1 = __builtin_nontemporal_load((const f32x4*)((const float*)base + off + bj * HALF + 4)); }
                    const f32x4 v0 = b0 + acc[ai][bj][m][0], v1 = b1 + acc[ai][bj][m][1];
                    if (OUT_F32) { __builtin_nontemporal_store(v0, (f32x4*)(out + off + bj * HALF)); __builtin_nontemporal_store(v1, (f32x4*)(out + off + bj * HALF + 4)); }
                    if (WITH_B) { u32x4 w; w.x = pkbf(v0[0], v0[1]); w.y = pkbf(v0[2], v0[3]); w.z = pkbf(v1[0], v1[1]); w.w = pkbf(v1[2], v1[3]); *(u32x4*)(xb + off + bj * HALF) = w;
                        s += (v0[0] * v0[0] + v0[1] * v0[1]) + (v0[2] * v0[2] + v0[3] * v0[3]) + (v1[0] * v1[0] + v1[1] * v1[1]) + (v1[2] * v1[2] + v1[3] * v1[3]); } }
                if (WITH_B) { s += __shfl_xor(s, 16); s += __shfl_xor(s, 32); if (fq == 0) ssn[(size_t)row * 16 + u.pn * 4 + wc] = s; } }
    }
};
struct EpiKVQ {
    static constexpr bool PERM = true, AFTER_DRAIN = false;
    bf16_t* O; const PG8_LAS float* rsb; const float* rope; const float* knorm; const float* qnorm;
    __device__ __forceinline__ void operator()(const f32x4 (&acc)[2][2][4][2], const Unit& u, int wr, int wc, int fr, int fq, int ui) const {
        const int row0 = u.pm * BM + wr * 64 + fr;
        if (u.pn >= 4 && u.pn < 8) {
            const int col0 = u.pn * BM + wc * 32 + 8 * fq;
#pragma unroll
            for (int ai = 0; ai < 2; ++ai)
#pragma unroll
                for (int m = 0; m < 4; ++m) { const int row = row0 + ai * HALF + m * 16; const float rs = rsb[ui * 256 + wr * 64 + fr + ai * HALF + m * 16]; bf16_t* rowp = O + (size_t)row * 3072 + col0;
#pragma unroll
                    for (int bj = 0; bj < 2; ++bj) { const f32x4 v0 = acc[ai][bj][m][0] * rs, v1 = acc[ai][bj][m][1] * rs;
                        u32x4 w; w.x = pkbf(v0[0], v0[1]); w.y = pkbf(v0[2], v0[3]); w.z = pkbf(v1[0], v1[1]); w.w = pkbf(v1[2], v1[3]); *(u32x4*)(rowp + bj * HALF) = w; } }
            return;
        }
        const bool isq = u.pn >= 8; const PG8_LAS float* nwl = rsb + 1024 + (isq ? 64 : 0) + 8 * fq; const float osc = isq ? 0.125f * 1.4426950408889634f : 1.0f;
        const int colg = u.pn * BM + wc * 64 + 8 * fq;
#pragma unroll
        for (int ai = 0; ai < 2; ++ai)
#pragma unroll
            for (int m = 0; m < 4; ++m) { const int row = row0 + ai * HALF + m * 16; const float rs = rsb[ui * 256 + wr * 64 + fr + ai * HALF + m * 16];
                const f32x4* rp = (const f32x4*)(rope + (size_t)row * 64 + 16 * fq);
                const f32x4 r0 = rp[0], r1 = rp[1], r2 = rp[2], r3 = rp[3];
                const float cs[8] = {r0[0], r0[2], r1[0], r1[2], r2[0], r2[2], r3[0], r3[2]}, sn[8] = {r0[1], r0[3], r1[1], r1[3], r2[1], r2[3], r3[1], r3[3]};
                float a[8], b[8]; float s2 = 0.f;
#pragma unroll
                for (int e = 0; e < 4; ++e) { a[e] = acc[ai][0][m][0][e] * rs; a[4 + e] = acc[ai][0][m][1][e] * rs; b[e] = acc[ai][1][m][0][e] * rs; b[4 + e] = acc[ai][1][m][1][e] * rs; }
#pragma unroll
                for (int e = 0; e < 8; ++e) s2 += a[e] * a[e] + b[e] * b[e];
                s2 += __shfl_xor(s2, 16); s2 += __shfl_xor(s2, 32);
                const float rn = rsqrtf(s2 * (1.0f / 64.0f) + 1e-6f) * osc;
                const f32x4 wa0 = *(const PG8_LAS f32x4*)nwl, wa1 = *(const PG8_LAS f32x4*)(nwl + 4), wb0 = *(const PG8_LAS f32x4*)(nwl + 32), wb1 = *(const PG8_LAS f32x4*)(nwl + 36);
                const float w1[8] = {wa0[0], wa0[1], wa0[2], wa0[3], wa1[0], wa1[1], wa1[2], wa1[3]}, w2[8] = {wb0[0], wb0[1], wb0[2], wb0[3], wb1[0], wb1[1], wb1[2], wb1[3]};
                float o1[8], o2[8];
#pragma unroll
                for (int e = 0; e < 8; ++e) { const float y1 = a[e] * rn * w1[e], y2 = b[e] * rn * w2[e]; o1[e] = y1 * cs[e] - y2 * sn[e]; o2[e] = y2 * cs[e] + y1 * sn[e]; }
                u32x4 wa, wb; wa.x = pkbf(o1[0], o1[1]); wa.y = pkbf(o1[2], o1[3]); wa.z = pkbf(o1[4], o1[5]); wa.w = pkbf(o1[6], o1[7]);
                wb.x = pkbf(o2[0], o2[1]); wb.y = pkbf(o2[2], o2[3]); wb.z = pkbf(o2[4], o2[5]); wb.w = pkbf(o2[6], o2[7]);
                bf16_t* rowp = O + (size_t)row * 3072 + colg; *(u32x4*)rowp = wa; *(u32x4*)(rowp + 32) = wb;
                asm volatile("" ::: "memory"); __builtin_amdgcn_sched_barrier(0); }
    }
};
template <class Epi, class Sched, bool ALIGN_EPI = false, bool SP2 = false>
__device__ __forceinline__ void gemm_phase(PG8_LAS unsigned char* lds, const Gemm g, const Sched& S, const Epi& E, int wave_in) {
    const int lane = fresh_lane(), wid = __builtin_amdgcn_readfirstlane(wave_in), tid = wid * 64 + lane, wr = wid >> 2, wc = wid & 3, fr = lane & 15, fq = lane >> 4;
    const int K = g.K, nt = K / BK;
    unsigned voffA[2], voffB[2];
#pragma unroll
    for (int i = 0; i < 2; ++i) { int R, C; stage_rc(tid * 16 + i * 8192, R, C); const int Rb = Epi::PERM ? ((R & ~31) + perm32(R & 31)) : R;
        voffA[i] = (unsigned)(R * K + C) * 2u; voffB[i] = (unsigned)(Rb * K + C) * 2u; }
    const size_t kstep = (size_t)(BK * 2);
    const size_t hstep = (size_t)HALF * K * 2;
    const size_t tstep = 2 * hstep;
    const unsigned ldsw = (unsigned)wid * 1024u;
    const int aoff = lds_byte(wr * 64 + fr, fq * 8), boff = lds_byte(wc * 32 + fr, fq * 8);
#define PG8_SA(b, h) (((b) * 2 + (h)) * HTB)
#define PG8_SB(b, h) ((4 + (b) * 2 + (h)) * HTB)
#define PG8_STAGE(bufoff, gbase, voff) do { _Pragma("unroll") for (int _i = 0; _i < 2; ++_i) \
        __builtin_amdgcn_global_load_lds((const unsigned*)((const char*)(gbase) + (voff)[_i]), (PG8_LAS unsigned*)(lds + (bufoff) + ldsw + _i * 8192), 16, 0, 0); } while (0)
#define PG8_LDA(dst, b, h) do { _Pragma("unroll") for (int m = 0; m < 4; ++m) _Pragma("unroll") for (int k = 0; k < 2; ++k) dst[m][k] = *(const PG8_LAS bf16x8*)(lds + PG8_SA(b, h) + aoff + m * 2048 + k * 1024); } while (0)
#define PG8_LDB(dst, b, h) do { _Pragma("unroll") for (int n = 0; n < 2; ++n) _Pragma("unroll") for (int k = 0; k < 2; ++k) dst[n][k] = *(const PG8_LAS bf16x8*)(lds + PG8_SB(b, h) + boff + n * 2048 + k * 1024); } while (0)
#define PG8_MMA(ai, bj, At, Bt) do { __builtin_amdgcn_s_setprio(1); _Pragma("unroll") for (int m = 0; m < 4; ++m) _Pragma("unroll") for (int n = 0; n < 2; ++n) _Pragma("unroll") for (int k = 0; k < 2; ++k) \
        acc[ai][bj][m][n] = __builtin_amdgcn_mfma_f32_16x16x32_bf16(Bt[n][k], At[m][k], acc[ai][bj][m][n], 0, 0, 0); __builtin_amdgcn_s_setprio(0); } while (0)
#define PG8_WAIT_V(n) asm volatile("s_waitcnt vmcnt(" #n ")" ::: "memory")
#define PG8_WAIT_L(n) asm volatile("s_waitcnt lgkmcnt(" #n ")" ::: "memory")
#define PG8_BAR __builtin_amdgcn_s_barrier()
#define PG8_SCHED __builtin_amdgcn_sched_barrier(0)
    Unit cur, nxt; int ui = 0;
    if (!S.next(0, cur)) return;
    f32x4 acc[2][2][4][2];
#pragma unroll
    for (int a = 0; a < 2; ++a)
#pragma unroll
        for (int b = 0; b < 2; ++b)
#pragma unroll
            for (int m = 0; m < 4; ++m)
#pragma unroll
                for (int n = 0; n < 2; ++n) acc[a][b][m][n] = (f32x4){0.f, 0.f, 0.f, 0.f};
    bf16x8 At[4][2], B0[2][2], B1[2][2];
    const char* cA = (const char*)g.A + (size_t)cur.pm * tstep; const char* cB = (const char*)g.Bt + (size_t)cur.pn * tstep;
    S.a_ready(cur);
    if constexpr (SP2) {
        PG8_STAGE(PG8_SB(0, 0), cB, voffB); PG8_STAGE(PG8_SB(0, 1), cB + hstep, voffB); PG8_STAGE(PG8_SA(0, 0), cA, voffA); PG8_STAGE(PG8_SA(0, 1), cA + hstep, voffA);
        if (wr == 1) PG8_BAR;
        PG8_WAIT_V(2); PG8_BAR;
        PG8_STAGE(PG8_SB(1, 0), cB + kstep, voffB); PG8_STAGE(PG8_SA(1, 0), cA + kstep, voffA); PG8_STAGE(PG8_SB(1, 1), cB + hstep + kstep, voffB);
        PG8_WAIT_V(6); PG8_BAR;
    } else {
        PG8_STAGE(PG8_SB(0, 0), cB, voffB); PG8_STAGE(PG8_SA(0, 0), cA, voffA); PG8_STAGE(PG8_SB(0, 1), cB + hstep, voffB); PG8_STAGE(PG8_SA(0, 1), cA + hstep, voffA);
        if (wr == 1) PG8_BAR;
        PG8_WAIT_V(4); PG8_BAR;
        PG8_STAGE(PG8_SB(1, 0), cB + kstep, voffB); PG8_STAGE(PG8_SA(1, 0), cA + kstep, voffA); PG8_STAGE(PG8_SB(1, 1), cB + hstep + kstep, voffB);
        PG8_WAIT_V(6); PG8_BAR;
    }
    for (;;) {
        const bool has_next = S.next(ui + 1, nxt);
        const char* nA = has_next ? (const char*)g.A + (size_t)nxt.pm * tstep : cA; const char* nB = has_next ? (const char*)g.Bt + (size_t)nxt.pn * tstep : cB;
        for (int t = 0; t < nt; t += 2) {
            const bool last = (t == nt - 2);
            const char* a1 = cA + (size_t)(t + 1) * kstep;
            const char* a2 = last ? nA : cA + (size_t)(t + 2) * kstep; const char* b2 = last ? nB : cB + (size_t)(t + 2) * kstep;
            const char* a3 = a2 + kstep; const char* b3 = b2 + kstep;
            if (last && has_next) S.a_ready(nxt);
            if constexpr (SP2) {
            PG8_LDB(B0, 0, 0); PG8_LDB(B1, 0, 1); PG8_SCHED; PG8_LDA(At, 0, 0); PG8_STAGE(PG8_SA(1, 1), a1 + hstep, voffA);
            PG8_WAIT_V(8); PG8_WAIT_L(0); PG8_BAR; PG8_MMA(0, 0, At, B0); PG8_MMA(0, 1, At, B1); PG8_BAR; PG8_SCHED;
            PG8_LDA(At, 0, 1); PG8_STAGE(PG8_SB(0, 0), b2, voffB); PG8_STAGE(PG8_SB(0, 1), b2 + hstep, voffB); PG8_STAGE(PG8_SA(0, 0), a2, voffA);
            PG8_WAIT_V(8); PG8_WAIT_L(0); PG8_BAR; PG8_MMA(1, 0, At, B0); PG8_MMA(1, 1, At, B1); PG8_BAR; PG8_SCHED;
            PG8_LDB(B0, 1, 0); PG8_LDB(B1, 1, 1); PG8_SCHED; PG8_LDA(At, 1, 0); PG8_STAGE(PG8_SA(0, 1), a2 + hstep, voffA);
            PG8_WAIT_V(8); PG8_WAIT_L(0); PG8_BAR; PG8_MMA(0, 0, At, B0); PG8_MMA(0, 1, At, B1); PG8_BAR; PG8_SCHED;
            PG8_LDA(At, 1, 1); PG8_STAGE(PG8_SB(1, 0), b3, voffB); PG8_STAGE(PG8_SB(1, 1), b3 + hstep, voffB); PG8_STAGE(PG8_SA(1, 0), a3, voffA);
            PG8_WAIT_V(8); PG8_WAIT_L(0); PG8_BAR; PG8_MMA(1, 0, At, B0); PG8_MMA(1, 1, At, B1); PG8_BAR; PG8_SCHED;
            } else {
            PG8_LDB(B0, 0, 0); PG8_SCHED; PG8_LDA(At, 0, 0); PG8_STAGE(PG8_SA(1, 1), a1 + hstep, voffA);
            PG8_WAIT_L(8); PG8_BAR; PG8_WAIT_L(0); PG8_MMA(0, 0, At, B0); PG8_BAR; PG8_SCHED;
            PG8_LDB(B1, 0, 1); PG8_STAGE(PG8_SB(0, 0), b2, voffB);
            PG8_BAR; PG8_WAIT_L(0); PG8_MMA(0, 1, At, B1); PG8_BAR;
            PG8_LDA(At, 0, 1); PG8_STAGE(PG8_SA(0, 0), a2, voffA);
            PG8_BAR; PG8_WAIT_L(0); PG8_MMA(1, 0, At, B0); PG8_BAR; PG8_SCHED;
            PG8_STAGE(PG8_SB(0, 1), b2 + hstep, voffB);
            PG8_WAIT_V(6); PG8_BAR; PG8_MMA(1, 1, At, B1); PG8_BAR;
            PG8_LDB(B0, 1, 0); PG8_SCHED; PG8_LDA(At, 1, 0); PG8_STAGE(PG8_SA(0, 1), a2 + hstep, voffA);
            PG8_WAIT_L(8); PG8_BAR; PG8_WAIT_L(0); PG8_MMA(0, 0, At, B0); PG8_BAR; PG8_SCHED;
            PG8_LDB(B1, 1, 1); PG8_STAGE(PG8_SB(1, 0), b3, voffB);
            PG8_BAR; PG8_WAIT_L(0); PG8_MMA(0, 1, At, B1); PG8_BAR;
            PG8_LDA(At, 1, 1); PG8_STAGE(PG8_SA(1, 0), a3, voffA);
            PG8_BAR; PG8_WAIT_L(0); PG8_MMA(1, 0, At, B0); PG8_BAR; PG8_SCHED;
            PG8_STAGE(PG8_SB(1, 1), b3 + hstep, voffB);
            PG8_WAIT_V(6); PG8_BAR; PG8_MMA(1, 1, At, B1); PG8_BAR;
            }
        }
        if constexpr (ALIGN_EPI) { if (wr == 0) PG8_BAR; }
        if constexpr (!Epi::AFTER_DRAIN) { E(acc, cur, wr, wc, fr, fq, ui); S.done(cur); }
        if (!has_next) break;
#pragma unroll
        for (int a = 0; a < 2; ++a)
#pragma unroll
            for (int b = 0; b < 2; ++b)
#pragma unroll
                for (int m = 0; m < 4; ++m)
#pragma unroll
                    for (int n = 0; n < 2; ++n) acc[a][b][m][n] = (f32x4){0.f, 0.f, 0.f, 0.f};
        cur = nxt; cA = nA; cB = nB; ++ui;
        if constexpr (ALIGN_EPI) { if (wr == 1) PG8_BAR; }
    }
    PG8_WAIT_V(0);
    if constexpr (!ALIGN_EPI) { if (wr == 0) PG8_BAR; }
    PG8_BAR;
    if constexpr (Epi::AFTER_DRAIN) { E.fused(acc, cur, wr, wc, fr, fq, lds, wid, lane); S.done(cur); }
#undef PG8_SA
#undef PG8_SB
#undef PG8_STAGE
#undef PG8_LDA
#undef PG8_LDB
#undef PG8_MMA
#undef PG8_WAIT_V
#undef PG8_WAIT_L
#undef PG8_BAR
#undef PG8_SCHED
}
}
#include <hip/hip_bf16.h>
#include <cmath>
namespace attn_body {
using bf16=__hip_bfloat16;
using bf16x8=__attribute__((ext_vector_type(8)))short;
using s16x4=__attribute__((ext_vector_type(4)))short;
using f32x16=__attribute__((ext_vector_type(16)))float;
using u32x4=__attribute__((ext_vector_type(4)))unsigned;
constexpr int BATCH=8,SEQ=2048,D=64,PQ=3072,PO=1024;
constexpr int NW=8,QBLK=32,QB=QBLK*NW,KVBLK=64,NQB=SEQ/QB;
constexpr int ATTN_UNIT_ROWS=QB;
__device__ __forceinline__ int crow(int r,int hi){return (r&3)+8*(r>>2)+4*hi;}
#define SBAR() __builtin_amdgcn_sched_barrier(0)
__device__ __forceinline__ void cmask(f32x16&p0,f32x16&p1,int jb,int qrel,int hi){
  const float NEG=-INFINITY; int kb=64*jb+4*hi;
  #pragma unroll
  for(int r=0;r<16;++r){int kv=kb+(r&3)+8*(r>>2); if(kv>qrel)p0[r]=NEG; if(kv+32>qrel)p1[r]=NEG;}
}

constexpr int NSLOT=3, SLOTB=8192;
constexpr int LDS_K=0, LDS_V=NSLOT*SLOTB, LDS_WS=2*NSLOT*SLOTB, LDS_OST=LDS_WS+NW*64*4, LDS_BYTES=LDS_OST+2*NW*4096;
constexpr float C2=0.125f*1.4426950408889634f;
__device__ __forceinline__ void glds16(const void*gsrc,unsigned lds_dst){unsigned keep;
  asm volatile("s_mov_b32 %0, m0\n\ts_mov_b32 m0, %2\n\ts_nop 0\n\tglobal_load_lds_dwordx4 %1, off\n\ts_mov_b32 m0, %0":"=&s"(keep):"v"(gsrc),"s"(lds_dst):"memory");}
__device__ __forceinline__ float max3f(float a,float b,float c){float r;asm("v_max3_f32 %0, %1, %2, %3":"=v"(r):"v"(a),"v"(b),"v"(c));return r;}
__device__ __forceinline__ float max2f(float a,float b){float r;asm("v_max_f32_e32 %0, %1, %2":"=v"(r):"v"(a),"v"(b));return r;}
__device__ __forceinline__ float fadd_s(float a,float b){float r;asm("v_add_f32_e32 %0, %1, %2":"=v"(r):"v"(a),"v"(b));return r;}
__device__ __forceinline__ float fsub_s(float a,float b){float r;asm("v_sub_f32_e32 %0, %1, %2":"=v"(r):"v"(a),"v"(b));return r;}
typedef float f32x2_t __attribute__((ext_vector_type(2))); typedef __bf16 bf16x2_t __attribute__((ext_vector_type(2)));
__device__ __forceinline__ unsigned cvtpk_s(float lo,float hi){f32x2_t v={lo,hi};bf16x2_t b=__builtin_convertvector(v,bf16x2_t);return __builtin_bit_cast(unsigned,b);}
#define WAIT_BAR(N) asm volatile("s_waitcnt vmcnt(" #N ") lgkmcnt(0)\n\ts_barrier":::"memory")

__device__ __forceinline__ void qkt(f32x16&p0,f32x16&p1,const char*Kslot,const bf16x8*qr,const f32x16&negm,int r32,int hi){
  const char*kb=Kslot+hi*1024+r32*16;
  #pragma unroll
  for(int d0=0;d0<4;++d0){
    const bf16x8 b0=*reinterpret_cast<const bf16x8*>(kb+d0*2048);
    const bf16x8 b1=*reinterpret_cast<const bf16x8*>(kb+d0*2048+512);
    if(d0==0){p0=__builtin_amdgcn_mfma_f32_32x32x16_bf16(b0,qr[0],negm,0,0,0);p1=__builtin_amdgcn_mfma_f32_32x32x16_bf16(b1,qr[0],negm,0,0,0);}
    else{p0=__builtin_amdgcn_mfma_f32_32x32x16_bf16(b0,qr[d0],p0,0,0,0);p1=__builtin_amdgcn_mfma_f32_32x32x16_bf16(b1,qr[d0],p1,0,0,0);}}
}
typedef __attribute__((address_space(3))) const char* lds_cptr;
typedef short v4i16_t __attribute__((ext_vector_type(4)));
__device__ __forceinline__ void kload8(bf16x8*kf,lds_cptr kp){
  kf[0]=*(const __attribute__((address_space(3))) bf16x8*)(kp);      kf[1]=*(const __attribute__((address_space(3))) bf16x8*)(kp+512);
  kf[2]=*(const __attribute__((address_space(3))) bf16x8*)(kp+2048); kf[3]=*(const __attribute__((address_space(3))) bf16x8*)(kp+2560);
  kf[4]=*(const __attribute__((address_space(3))) bf16x8*)(kp+4096); kf[5]=*(const __attribute__((address_space(3))) bf16x8*)(kp+4608);
  kf[6]=*(const __attribute__((address_space(3))) bf16x8*)(kp+6144); kf[7]=*(const __attribute__((address_space(3))) bf16x8*)(kp+6656);
}
__device__ __forceinline__ void kload2(bf16x8*kf,lds_cptr kp,int j){ kf[2*j]=*(const __attribute__((address_space(3))) bf16x8*)(kp+j*2048); kf[2*j+1]=*(const __attribute__((address_space(3))) bf16x8*)(kp+j*2048+512); }
__device__ __forceinline__ s16x4 vtr(lds_cptr p){ return __builtin_bit_cast(s16x4,__builtin_amdgcn_ds_read_tr16_b64_v4i16((__attribute__((address_space(3))) v4i16_t*)p)); }
__device__ __forceinline__ float rowmax(const f32x16&p0,const f32x16&p1){
  float a=max3f(p0[0],p0[1],p1[0]),b=max3f(p0[2],p0[3],p1[1]);a=max3f(a,p1[2],p1[3]);
  #pragma unroll
  for(int r=4;r<16;r+=4){a=max3f(a,p0[r],p0[r+1]);b=max3f(b,p0[r+2],p0[r+3]);a=max3f(a,p1[r],p1[r+1]);b=max3f(b,p1[r+2],p1[r+3]);}
  const float m=max2f(a,b);
  auto rr=__builtin_amdgcn_permlane32_swap(__float_as_uint(m),__float_as_uint(m),false,false);
  return max2f(__uint_as_float(rr[0]),__uint_as_float(rr[1]));
}
__device__ __forceinline__ void pv(f32x16*o,int vb,bf16x8 pa0,bf16x8 pa1,bf16x8 pa2,bf16x8 pa3){
  #pragma unroll
  for(int d0=0;d0<2;++d0){s16x4 lo[4],hi[4];
    #pragma unroll
    for(int ks=0;ks<4;++ks){
      asm volatile("ds_read_b64_tr_b16 %0,%1 offset:%c2":"=&v"(lo[ks]):"v"(vb),"i"(d0*4096+ks*1024):"memory");
      asm volatile("ds_read_b64_tr_b16 %0,%1 offset:%c2":"=&v"(hi[ks]):"v"(vb),"i"(d0*4096+ks*1024+512):"memory");}
    asm volatile("s_waitcnt lgkmcnt(0)":::"memory");SBAR();
    #define PK(k) (bf16x8){lo[k][0],lo[k][1],lo[k][2],lo[k][3],hi[k][0],hi[k][1],hi[k][2],hi[k][3]}
    o[d0]=__builtin_amdgcn_mfma_f32_32x32x16_bf16(pa0,PK(0),o[d0],0,0,0);
    o[d0]=__builtin_amdgcn_mfma_f32_32x32x16_bf16(pa1,PK(1),o[d0],0,0,0);
    o[d0]=__builtin_amdgcn_mfma_f32_32x32x16_bf16(pa2,PK(2),o[d0],0,0,0);
    o[d0]=__builtin_amdgcn_mfma_f32_32x32x16_bf16(pa3,PK(3),o[d0],0,0,0);
    #undef PK
  }
}

#ifndef ATTN_STORE16
#define ATTN_STORE16(p,v) (*(u32x4*)(p)=(v))
#endif
template<int THRL> __device__ __forceinline__ void attn_unit(int b,int h,int qb,const bf16*Q,const bf16*__restrict__ K,const bf16*__restrict__ V,bf16*O,char*shm,int mode,int hfsel,float lam,bool fin,const float*__restrict__ subw){
  int lane; asm volatile("v_mbcnt_lo_u32_b32 %0, -1, 0\n\tv_mbcnt_hi_u32_b32 %0, -1, %0" : "=v"(lane)); const int r32=lane&31,hi=lane>>5; const int wid=__builtin_amdgcn_readfirstlane(h);
  const long rowbase=(long)b*SEQ; const int q0=qb*QB;
  const bf16*Qw=Q+(rowbase+q0+wid*QBLK)*PQ;
  const bf16*Kh=K+rowbase*PQ,*Vh=V+rowbase*PQ;
  const unsigned lds0=(unsigned)(uintptr_t)shm;
  float*wsf=(float*)(shm+LDS_WS)+wid*64;
  const bf16*ksrc=Kh+(long)lane*PQ+wid*8;
  const bf16*vsrc=Vh+(long)(16*(wid&3)+(lane>>2))*PQ+(wid>>2)*32+(lane&3)*8;
  const unsigned kdst=lds0+LDS_K+wid*1024, vdst=lds0+LDS_V+wid*1024;
  #define DMA_K(t,slot) glds16(ksrc+(long)(t)*KVBLK*PQ,(unsigned)__builtin_amdgcn_readfirstlane(kdst+(slot)))
  #define DMA_V(t,slot) glds16(vsrc+(long)(t)*KVBLK*PQ,(unsigned)__builtin_amdgcn_readfirstlane(vdst+(slot)))
  const int vb0=(int)(lds0+LDS_V)+((lane>>4)&1)*32+(lane&3)*8+(4*hi+((lane&15)>>2))*64;
  const char*Kbase=shm+LDS_K; bf16x8 kf[8];
  const lds_cptr shm3=(lds_cptr)shm; const lds_cptr kp0=shm3+LDS_K+hi*1024+r32*16; const lds_cptr vp0=shm3+LDS_V+((lane>>4)&1)*32+(lane&3)*8+(4*hi+((lane&15)>>2))*64;
  const int NT=(q0+QB)/KVBLK;
  DMA_K(0,0);DMA_V(0,0);DMA_K(1,SLOTB);
  bf16x8 qr[4];
  #pragma unroll
  for(int d0=0;d0<4;++d0)qr[d0]=*reinterpret_cast<const bf16x8*>(&Qw[(long)r32*PQ+d0*16+hi*8]);
  float mhat=0.f,l_reg=0.f;float zz_;asm volatile("v_mov_b32 %0, 0":"=v"(zz_));f32x16 o[2];f32x16 negm;
  #pragma unroll
  for(int r=0;r<16;++r){o[0][r]=zz_;o[1][r]=zz_;negm[r]=zz_;}
  asm volatile("":"+v"(negm));
  const int qrel=wid*QBLK+r32;
  #define CMASK(P0,P1,t) do{int jb_=(t)-(NT-4); if(jb_>=0)cmask(P0,P1,jb_,qrel,hi);}while(0)
  bool resc=false;
  #define START(P0,P1) do{ const float rm=rowmax(P0,P1); resc=false; \
    { const float dl=rm; mhat=fadd_s(mhat,dl); \
      _Pragma("unroll") for(int r=0;r<16;++r){P0[r]=fsub_s(P0[r],dl);P1[r]=fsub_s(P1[r],dl);} \
      _Pragma("unroll") for(int r=0;r<16;++r)negm[r]=-mhat; asm volatile("":"+v"(negm)); } \
    _Pragma("unroll") for(int r=0;r<16;++r)P0[r]=__builtin_amdgcn_exp2f(P0[r]); }while(0)
  #define RESC() do{ if(resc){ asm volatile("s_waitcnt lgkmcnt(0)":::"memory"); \
      _Pragma("unroll") for(int d_=0;d_<2;++d_) _Pragma("unroll") for(int r=0;r<16;++r)o[d_][r]*=wsf[crow(r,hi)]; } }while(0)
  f32x16 pA0,pA1,pB0,pB1;
  int sl_prev=0,sl_cur=0,sl_next=SLOTB;
  #define ROT() do{sl_prev=sl_cur;sl_cur=sl_next;sl_next=(sl_next==(NSLOT-1)*SLOTB)?0:sl_next+SLOTB;}while(0)
  DMA_K(2,2*SLOTB);
  WAIT_BAR(3);
  qkt(pA0,pA1,Kbase,qr,negm,r32,hi);asm volatile("s_nop 15\n\ts_nop 7":"+v"(pA0),"+v"(pA1));CMASK(pA0,pA1,0);
  START(pA0,pA1);
  _Pragma("unroll") for(int r=0;r<16;++r)pA1[r]=__builtin_amdgcn_exp2f(pA1[r]);
  WAIT_BAR(0);
  DMA_K(3,0);DMA_V(1,SLOTB);
  ROT();
  kload8(kf,kp0+sl_cur);
  WAIT_BAR(2);
  s16x4 vlo[8],vhi[8]; u32x4 pw0,pw1,pw2,pw3;
  #define PKW(P,B) cvtpk_s(P[B],P[B+1])
  #define PAF(k) __builtin_bit_cast(bf16x8,pw##k)
  #define VFR(i) (bf16x8){vlo[i][0],vlo[i][1],vlo[i][2],vlo[i][3],vhi[i][0],vhi[i][1],vhi[i][2],vhi[i][3]}
  #define PIN(x) asm volatile("":"+v"(x))
  #define MX3(a,b,c) __builtin_fmaxf(__builtin_fmaxf((a),(b)),(c))
  #define GAPA(MF,A0,A1,A2,A3,W0,W1,PW) do{ MF; sacc+=A0; sacc+=A1; sacc+=A2; sacc+=A3; PIN(sacc); W0; W1; PIN(PW); SBAR(); }while(0)
  #define EX(v) __builtin_amdgcn_exp2f(v)
  #define GAPB(MF,X,B) do{ MF; X[B]=EX(X[B]); X[B+1]=EX(X[B+1]); X[B+2]=EX(X[B+2]); X[B+3]=EX(X[B+3]); PIN(X); SBAR(); }while(0)
  #define VRD(i) do{ vlo[i]=vtr(vp_+(((i)>>2)*4096+((i)&3)*1024)); vhi[i]=vtr(vp_+(((i)>>2)*4096+((i)&3)*1024+512)); }while(0)
  #define KRD(G,j) do{ if(G){ kload2(kf,kp0+sl_next,j); SBAR(); } }while(0)
  #define STEP(C0,C1,P0,P1,t,GK,GV,GL) do{ SBAR(); \
    const lds_cptr vp_=vp0+sl_prev; \
    VRD(0); SBAR(); float sacc=(P0[0]+P0[1]); \
    GAPA(C0=__builtin_amdgcn_mfma_f32_32x32x16_bf16(kf[0],qr[0],negm,0,0,0), P0[2],P0[3],P0[4],P0[5],     pw0[0]=PKW(P0,0), pw0[1]=PKW(P0,2), pw0); \
    VRD(4); SBAR(); GAPA(C1=__builtin_amdgcn_mfma_f32_32x32x16_bf16(kf[1],qr[0],negm,0,0,0), P0[6],P0[7],P0[8],P0[9],     pw0[2]=PKW(P0,4), pw0[3]=PKW(P0,6), pw0); \
    VRD(1); SBAR(); GAPA(C0=__builtin_amdgcn_mfma_f32_32x32x16_bf16(kf[2],qr[1],C0,0,0,0),   P0[10],P0[11],P0[12],P0[13], pw1[0]=PKW(P0,8), pw1[1]=PKW(P0,10), pw1); \
    VRD(5); SBAR(); GAPA(C1=__builtin_amdgcn_mfma_f32_32x32x16_bf16(kf[3],qr[1],C1,0,0,0),   P0[14],P0[15],P1[0],P1[1],   pw1[2]=PKW(P0,12),pw1[3]=PKW(P0,14), pw1); \
    VRD(2); SBAR(); GAPA(C0=__builtin_amdgcn_mfma_f32_32x32x16_bf16(kf[4],qr[2],C0,0,0,0),   P1[2],P1[3],P1[4],P1[5],     pw2[0]=PKW(P1,0), pw2[1]=PKW(P1,2), pw2); \
    VRD(6); SBAR(); GAPA(C1=__builtin_amdgcn_mfma_f32_32x32x16_bf16(kf[5],qr[2],C1,0,0,0),   P1[6],P1[7],P1[8],P1[9],     pw2[2]=PKW(P1,4), pw2[3]=PKW(P1,6), pw2); \
    VRD(3); SBAR(); GAPA(C0=__builtin_amdgcn_mfma_f32_32x32x16_bf16(kf[6],qr[3],C0,0,0,0),   P1[10],P1[11],P1[12],P1[13], pw3[0]=PKW(P1,8), pw3[1]=PKW(P1,10), pw3); \
    VRD(7); SBAR(); GAPA(C1=__builtin_amdgcn_mfma_f32_32x32x16_bf16(kf[7],qr[3],C1,0,0,0),   P1[14],P1[15],0.f,0.f,       pw3[2]=PKW(P1,12),pw3[3]=PKW(P1,14), pw3); \
    l_reg+=sacc; \
    if(GK){DMA_K((t)+3,sl_cur);} if(GV){DMA_V((t)+1,sl_next);} \
    CMASK(C0,C1,t); \
    { float a=MX3(C0[0],C0[1],C1[0]),b=MX3(C0[2],C0[3],C1[1]); a=MX3(a,C1[2],C1[3]); \
      _Pragma("unroll") for(int r=4;r<16;r+=4){a=MX3(a,C0[r],C0[r+1]);b=MX3(b,C0[r+2],C0[r+3]);a=MX3(a,C1[r],C1[r+1]);b=MX3(b,C1[r+2],C1[r+3]);} \
      float rm=__builtin_fmaxf(a,b); { auto rr=__builtin_amdgcn_permlane32_swap(__float_as_uint(rm),__float_as_uint(rm),false,false); rm=__builtin_fmaxf(__uint_as_float(rr[0]),__uint_as_float(rr[1])); } \
      resc=false; \
      if(__builtin_expect(__any(rm>(float)THRL),0)){ const float dl=__builtin_fmaxf(rm,0.f); mhat+=dl; \
        _Pragma("unroll") for(int r=0;r<16;++r){C0[r]-=dl;C1[r]-=dl;} \
        _Pragma("unroll") for(int r=0;r<16;++r)negm[r]=-mhat; asm volatile("":"+v"(negm)); \
        const float f=__builtin_amdgcn_exp2f(-dl); l_reg*=f; if(hi==0)wsf[r32]=f; resc=true; } } \
    SBAR(); \
    GAPB(o[0]=__builtin_amdgcn_mfma_f32_32x32x16_bf16(PAF(0),VFR(0),o[0],0,0,0), C0,0); \
    GAPB(o[1]=__builtin_amdgcn_mfma_f32_32x32x16_bf16(PAF(0),VFR(4),o[1],0,0,0), C0,4); \
    KRD(GL,0); GAPB(o[0]=__builtin_amdgcn_mfma_f32_32x32x16_bf16(PAF(1),VFR(1),o[0],0,0,0), C0,8); \
    KRD(GL,1); GAPB(o[1]=__builtin_amdgcn_mfma_f32_32x32x16_bf16(PAF(1),VFR(5),o[1],0,0,0), C0,12); \
    KRD(GL,2); GAPB(o[0]=__builtin_amdgcn_mfma_f32_32x32x16_bf16(PAF(2),VFR(2),o[0],0,0,0), C1,0); \
    KRD(GL,3); GAPB(o[1]=__builtin_amdgcn_mfma_f32_32x32x16_bf16(PAF(2),VFR(6),o[1],0,0,0), C1,4); \
    GAPB(o[0]=__builtin_amdgcn_mfma_f32_32x32x16_bf16(PAF(3),VFR(3),o[0],0,0,0), C1,8); \
    GAPB(o[1]=__builtin_amdgcn_mfma_f32_32x32x16_bf16(PAF(3),VFR(7),o[1],0,0,0), C1,12); \
    }while(0)
  int t=1;
  #undef CMASK
  #define CMASK(P0,P1,t) do{}while(0)
  for(;t+5<NT;t+=2){
    STEP(pB0,pB1,pA0,pA1,t,true,true,true);     WAIT_BAR(2); RESC(); ROT();
    STEP(pA0,pA1,pB0,pB1,t+1,true,true,true);   WAIT_BAR(2); RESC(); ROT();
  }
  #undef CMASK
  #define CMASK(P0,P1,t) do{int jb_=(t)-(NT-4); if(jb_>=0)cmask(P0,P1,jb_,qrel,hi);}while(0)
  #define ENDW(tt) do{ if((tt)+3<NT){WAIT_BAR(2);} else if((tt)+2<NT){WAIT_BAR(1);} else {WAIT_BAR(0);} }while(0)
  for(;t+1<NT;t+=2){
    STEP(pB0,pB1,pA0,pA1,t,(t+3<NT),(t+1<NT),(t+1<NT));       ENDW(t);   RESC(); ROT();
    STEP(pA0,pA1,pB0,pB1,t+1,(t+4<NT),(t+2<NT),(t+2<NT));     ENDW(t+1); RESC(); ROT();
  }
  STEP(pB0,pB1,pA0,pA1,NT-1,false,false,false); RESC();
  { float sacc=pB0[0]+pB0[1]; _Pragma("unroll") for(int r=2;r<16;++r)sacc+=pB0[r]; _Pragma("unroll") for(int r=0;r<16;++r)sacc+=pB1[r]; l_reg+=sacc;
    pw0=(u32x4){PKW(pB0,0),PKW(pB0,2),PKW(pB0,4),PKW(pB0,6)};pw1=(u32x4){PKW(pB0,8),PKW(pB0,10),PKW(pB0,12),PKW(pB0,14)};pw2=(u32x4){PKW(pB1,0),PKW(pB1,2),PKW(pB1,4),PKW(pB1,6)};pw3=(u32x4){PKW(pB1,8),PKW(pB1,10),PKW(pB1,12),PKW(pB1,14)};
    SBAR(); pv(o,vb0+sl_cur,PAF(0),PAF(1),PAF(2),PAF(3)); }
  #undef PKW
  #undef PAF
  #undef VFR
  #undef PIN
  #undef MX3
  #undef GAPA
  #undef GAPB
  #undef EX
  #undef VRD
  #undef KRD
  #undef STEP
  #undef ENDW
  {auto rr=__builtin_amdgcn_permlane32_swap(__float_as_uint(l_reg),__float_as_uint(l_reg),false,false);l_reg=__uint_as_float(rr[0])+__uint_as_float(rr[1]);}
  if(hi==0)wsf[32+r32]=l_reg;asm volatile("s_waitcnt lgkmcnt(0)":::"memory");
  float rli[16];
  #pragma unroll
  for(int r=0;r<16;++r)rli[r]=__builtin_amdgcn_rcpf(wsf[32+crow(r,hi)]);
  { bf16*stg=(bf16*)(shm+LDS_OST+hfsel*(NW*4096))+wid*2048;
    #pragma unroll
    for(int r=0;r<16;++r){const int orow=crow(r,hi);
      #pragma unroll
      for(int d0=0;d0<2;++d0){ const int idx=orow*64+d0*32+r32; float val=o[d0][r]*rli[r]; if(mode) val=__bfloat162float(stg[idx])-lam*val; stg[idx]=__float2bfloat16(val); } }
    asm volatile("s_waitcnt lgkmcnt(0)":::"memory");
    if(fin){ const bf16*s0=(const bf16*)(shm+LDS_OST)+wid*2048; const bf16*s1=s0+NW*2048;
      bf16*Ow=O+(rowbase+q0+wid*QBLK)*PO; const int ch=lane&7;
      float w0[8],w1[8];
      #pragma unroll
      for(int e=0;e<8;++e){ w0[e]=subw[ch*8+e]; w1[e]=subw[64+ch*8+e]; }
      #pragma unroll
      for(int i=0;i<4;++i){ const int row=i*8+(lane>>3);
        const u32x4 a=*(const u32x4*)(s0+row*64+ch*8), c=*(const u32x4*)(s1+row*64+ch*8);
        float x0[8]={__uint_as_float(a[0]<<16),__uint_as_float(a[0]&0xffff0000u),__uint_as_float(a[1]<<16),__uint_as_float(a[1]&0xffff0000u),__uint_as_float(a[2]<<16),__uint_as_float(a[2]&0xffff0000u),__uint_as_float(a[3]<<16),__uint_as_float(a[3]&0xffff0000u)};
        float x1[8]={__uint_as_float(c[0]<<16),__uint_as_float(c[0]&0xffff0000u),__uint_as_float(c[1]<<16),__uint_as_float(c[1]&0xffff0000u),__uint_as_float(c[2]<<16),__uint_as_float(c[2]&0xffff0000u),__uint_as_float(c[3]<<16),__uint_as_float(c[3]&0xffff0000u)};
        float ss=0.f;
        #pragma unroll
        for(int e=0;e<8;++e) ss+=x0[e]*x0[e]+x1[e]*x1[e];
        ss+=__shfl_xor(ss,1); ss+=__shfl_xor(ss,2); ss+=__shfl_xor(ss,4);
        const float rs=rsqrtf(ss*(1.0f/128.0f)+1e-6f);
        u32x4 v0,v1;
        v0[0]=cvtpk_s(x0[0]*rs*w0[0],x0[1]*rs*w0[1]); v0[1]=cvtpk_s(x0[2]*rs*w0[2],x0[3]*rs*w0[3]); v0[2]=cvtpk_s(x0[4]*rs*w0[4],x0[5]*rs*w0[5]); v0[3]=cvtpk_s(x0[6]*rs*w0[6],x0[7]*rs*w0[7]);
        v1[0]=cvtpk_s(x1[0]*rs*w1[0],x1[1]*rs*w1[1]); v1[1]=cvtpk_s(x1[2]*rs*w1[2],x1[3]*rs*w1[3]); v1[2]=cvtpk_s(x1[4]*rs*w1[4],x1[5]*rs*w1[5]); v1[3]=cvtpk_s(x1[6]*rs*w1[6],x1[7]*rs*w1[7]);
        ATTN_STORE16(Ow+(long)row*PO+ch*8,v0); ATTN_STORE16(Ow+(long)row*PO+64+ch*8,v1); } } }
  asm volatile("s_waitcnt lgkmcnt(0)\n\ts_barrier":::"memory");
  #undef DMA_K
  #undef DMA_V
  #undef CMASK
  #undef START
  #undef RESC
  #undef ROT
}
constexpr int ATTN_LDS_BYTES=LDS_BYTES;
#undef SBAR
#undef WAIT_BAR
}
#define LAS __attribute__((address_space(3)))
typedef unsigned short bf16;
typedef unsigned v4u __attribute__((ext_vector_type(4)));
typedef unsigned v2u __attribute__((ext_vector_type(2)));
typedef float f32x4 __attribute__((ext_vector_type(4)));
typedef short bf16x8 __attribute__((ext_vector_type(8)));
typedef float f32x2_g __attribute__((ext_vector_type(2)));
constexpr int NB = 8, SEQ = 2048, DM = 1024, FF = 4096, NH = 8, M = NB * SEQ, NWAVES = 8;
constexpr float EPS = 1e-6f;
constexpr size_t MiB = 1u << 20;
constexpr size_t WS_SS = 0, WS_BA = 4 * MiB, WS_CD = 5 * MiB, WS_WOA = 6 * MiB, WS_WIN = 8 * MiB, WS_XB = 16 * MiB, WS_P = 48 * MiB;
constexpr size_t WS_W = 144 * MiB, WS_QD = 176 * MiB, WS_KDT = 208 * MiB, WS_IN = 240 * MiB, WS_U = 16 * MiB;
constexpr size_t WS_W10 = 208 * MiB, WS_W20 = 216 * MiB, WS_WKVQ = 224 * MiB, WS_WOB = 230 * MiB, WS_W11 = 232 * MiB, WS_W21 = 240 * MiB;
constexpr size_t WS_OG = 48 * MiB, WS_H = 80 * MiB, WS_KVQ = 48 * MiB, WS_AO = 144 * MiB, WS_OD = 16 * MiB, WS_X3B = 48 * MiB, WS_END = 256 * MiB;
constexpr int LDS_BYTES = 147456;
constexpr size_t WS_ROPE = 8 * MiB;
constexpr size_t WS_BAR = 5 * MiB + 65536;
constexpr int LDS_BARST = 147440;

__device__ __forceinline__ float wave_sum(float v) {
#pragma unroll
    for (int o = 1; o < 64; o <<= 1) v += __shfl_xor(v, o);
    return v;
}
__device__ __forceinline__ unsigned pk2(float lo, float hi) { return pg8::pkbf(lo, hi); }
__device__ __forceinline__ float bflo(unsigned u) { return __uint_as_float(u << 16); }
__device__ __forceinline__ float bfhi(unsigned u) { return __uint_as_float(u & 0xffff0000u); }
__device__ __forceinline__ unsigned short f2bf1(float f) { return (unsigned short)(pk2(f, 0.f) & 0xffffu); }

struct Frame { LAS unsigned char* lds; int wave, vcu, G; };

__device__ __forceinline__ void transpose_item(const float* W, int ldw, int col_off, int K, int ncols, const float* nscale, bf16* WT, int row_off, int perm, LAS float* scr, int item, int lane) {
    const int nblk = ncols / 64, kb = item / nblk, nb = item % nblk, k0 = 64 * kb, n0 = 64 * nb, n4 = lane & 15, kr = lane >> 4;
    f32x4 v[16]; float sc[16];
#pragma unroll
    for (int i = 0; i < 16; ++i) { const int kk = 4 * i + kr; v[i] = __builtin_nontemporal_load((const f32x4*)(W + (size_t)(k0 + kk) * ldw + col_off + n0 + 4 * n4));     sc[i] = nscale ? nscale[k0 + kk] : 1.0f; }
#pragma unroll
    for (int i = 0; i < 16; ++i) { const int kk = 4 * i + kr; LAS float* d = scr + kk * 65 + 4 * n4; d[0] = v[i][0] * sc[i]; d[1] = v[i][1] * sc[i]; d[2] = v[i][2] * sc[i]; d[3] = v[i][3] * sc[i]; }
    asm volatile("s_waitcnt lgkmcnt(0)" ::: "memory");
#pragma unroll
    for (int j = 0; j < 8; ++j) { const int p = lane + 64 * j, n = p >> 3, c = p & 7; const LAS float* s = scr + (8 * c) * 65 + n;
        v4u o; o.x = pk2(s[0 * 65], s[1 * 65]); o.y = pk2(s[2 * 65], s[3 * 65]); o.z = pk2(s[4 * 65], s[5 * 65]); o.w = pk2(s[6 * 65], s[7 * 65]);
        const int cs_ = n0 + n, dr = perm ? ((cs_ & ~255) + 128 * ((cs_ >> 5) & 1) + 32 * ((cs_ >> 6) & 3) + (cs_ & 31)) : cs_;
        *(v4u*)(WT + (size_t)(row_off + dr) * K + k0 + 8 * c) = o; }
    asm volatile("s_waitcnt lgkmcnt(0)" ::: "memory");
}
struct TrJob { const float* W; int ldw, col_off, K, ncols; const float* nscale; bf16* WT; int row_off; int perm; };
template <int NJ> __device__ __forceinline__ void run_transposes(const Frame& F, const TrJob (&jobs)[NJ], int lane) {
    LAS float* scr = (LAS float*)(F.lds + F.wave * 17408);
    const int gw = F.vcu * NWAVES + F.wave, NGW = F.G * NWAVES;
    int total = 0;
#pragma unroll
    for (int j = 0; j < NJ; ++j) total += (jobs[j].K / 64) * (jobs[j].ncols / 64);
    for (int it = gw; it < total; it += NGW) {
        int r = it;
#pragma unroll
        for (int j = 0; j < NJ; ++j) { const int n = (jobs[j].K / 64) * (jobs[j].ncols / 64);
            if (r >= 0 && r < n) transpose_item(jobs[j].W, jobs[j].ldw, jobs[j].col_off, jobs[j].K, jobs[j].ncols, jobs[j].nscale, jobs[j].WT, jobs[j].row_off, jobs[j].perm, scr, r, lane);
            r -= n; }
    }
}

struct Args { const void* in[21]; float* out; unsigned char* ws; };

__device__ __forceinline__ bool xb_tid0() { return (__builtin_amdgcn_readfirstlane((int)threadIdx.x >> 6) == 0) && (fresh_lane() == 0); }
#define XB_TMO      128
#define XB_XCNT(j)  (256  + 64 * (j))
#define XB_XSUB(j)  (1280 + 64 * (j))
#define XB_XGEN(j)  (2304 + 64 * (j))
#define XB_TOP      3328
#define XB_TOPGEN   3392
#define XCD_BAR_WORDS 3456
#define XB_SPIN_CAP (1u << 18)

__device__ __forceinline__ unsigned xb_ld(unsigned* p)              { return __hip_atomic_load(p, __ATOMIC_RELAXED, __HIP_MEMORY_SCOPE_AGENT); }
__device__ __forceinline__ unsigned xb_add(unsigned* p, unsigned v) { return __hip_atomic_fetch_add(p, v, __ATOMIC_RELAXED, __HIP_MEMORY_SCOPE_AGENT); }
__device__ __forceinline__ unsigned xb_xcc_id() { return (unsigned)__builtin_amdgcn_s_getreg((3 << 11) | 20) & 0xFu; }
#define XB_SPIN(cond, bar) do { unsigned _sp = 0; while (cond) { __builtin_amdgcn_s_sleep(1); \
    if ((++_sp & 255u) == 0u) { if (xb_ld(&(bar)[XB_TMO])) break; if (_sp > XB_SPIN_CAP) { atomicAdd(&(bar)[XB_TMO], 1u); break; } } } } while (0)

struct XcdBarrier {
    unsigned* bar; unsigned x;
    volatile LAS unsigned* st;
};

__device__ __forceinline__ XcdBarrier xcd_barrier_post(unsigned* bar, volatile LAS unsigned* st) {
    XcdBarrier b; b.bar = bar; b.x = xb_xcc_id(); b.st = st;
    if (xb_tid0()) (void)xb_add(&bar[XB_XCNT(b.x)], 1u);
    return b;
}
__device__ __forceinline__ void xcd_barrier_complete(unsigned* bar, unsigned x, unsigned& nloc, unsigned& nx) {
    const unsigned G = gridDim.x * gridDim.y * gridDim.z;
    unsigned sum, cnt, mine, sp = 0u;
    for (;;) {
        sum = 0u; cnt = 0u; mine = 0u;
#pragma unroll
        for (unsigned j = 0; j < 16; ++j) { const unsigned c = xb_ld(&bar[XB_XCNT(j)]); sum += c; cnt += (c > 0u) ? 1u : 0u; mine = (j == x) ? c : mine; }
        if (sum == G) break;
        __builtin_amdgcn_s_sleep(1);
        if ((++sp & 255u) == 0u) { if (xb_ld(&bar[XB_TMO])) break; if (sp > XB_SPIN_CAP) { atomicAdd(&bar[XB_TMO], 1u); break; } }
    }
    nloc = mine > 0u ? mine : 1u; nx = cnt > 0u ? cnt : 1u;
}

__device__ __forceinline__ void xcd_barrier(const XcdBarrier& b) {
    asm volatile("s_waitcnt vmcnt(0)" ::: "memory");
    __syncthreads();
    if (xb_tid0()) {
        unsigned* bar = b.bar;
        __builtin_amdgcn_s_waitcnt(0);
        unsigned nloc = b.st[0], nx = b.st[1];
        if (nloc == 0u) { xcd_barrier_complete(bar, b.x, nloc, nx); b.st[0] = nloc; b.st[1] = nx; }
        const unsigned old = xb_add(&bar[XB_XSUB(b.x)], 1u);
        const unsigned gen = old / nloc;
        if (old + 1u == (gen + 1u) * nloc) {
            __builtin_amdgcn_fence(__ATOMIC_RELEASE, "agent");
            asm volatile("s_waitcnt vmcnt(0)" ::: "memory");
            const unsigned og = xb_add(&bar[XB_TOP], 1u);
            const unsigned tg = og / nx;
            if (og + 1u == (tg + 1u) * nx) xb_add(&bar[XB_TOPGEN], 1u);
            else XB_SPIN(xb_ld(&bar[XB_TOPGEN]) == tg, bar);
            __builtin_amdgcn_fence(__ATOMIC_ACQUIRE, "agent");
            xb_add(&bar[XB_XGEN(b.x)], 1u);
            asm volatile("s_waitcnt vmcnt(0)" ::: "memory");
        } else {
            XB_SPIN(xb_ld(&bar[XB_XGEN(b.x)]) == gen, bar);
            __builtin_amdgcn_fence(__ATOMIC_ACQUIRE, "agent");
            asm volatile("s_waitcnt vmcnt(0)" ::: "memory");
        }
    }
    __syncthreads();
}

__device__ __forceinline__ void phase_prologue(const Frame& F, const Args& A) {
    const float* x = (const float*)A.in[0]; const float* a_norm = (const float*)A.in[2]; const float* w_in = (const float*)A.in[3];
    unsigned char* ws = A.ws; const int lane = fresh_lane(), tid = F.wave * 64 + lane;
    LAS float* w16 = (LAS float*)F.lds;
    for (int e = tid; e < 16384; e += 512) { const int k = e >> 4, c = e & 15; w16[c * 1024 + k] = a_norm[k] * w_in[(size_t)k * 4112 + 4096 + c]; }
    __syncthreads();
    const int gw = F.vcu * NWAVES + F.wave, NGW = F.G * NWAVES;
    float* SS0 = (float*)(ws + WS_SS); float* BA = (float*)(ws + WS_BA); bf16* XB = (bf16*)(ws + WS_XB);
    f32x4 vnx[4];
    { const f32x4* xr = (const f32x4*)(x + (size_t)gw * DM) + lane;
#pragma unroll
      for (int j = 0; j < 4; ++j) vnx[j] = __builtin_nontemporal_load(xr + 64 * j); }
    for (int row = gw; row < M; row += NGW) {
        f32x4 v[4]; float s = 0.f;
#pragma unroll
        for (int j = 0; j < 4; ++j) v[j] = vnx[j];
        { const int nrow = (row + NGW < M) ? row + NGW : row; const f32x4* xr = (const f32x4*)(x + (size_t)nrow * DM) + lane;
#pragma unroll
          for (int j = 0; j < 4; ++j) vnx[j] = __builtin_nontemporal_load(xr + 64 * j); }
#pragma unroll
        for (int j = 0; j < 4; ++j) s += (v[j][0] * v[j][0] + v[j][1] * v[j][1]) + (v[j][2] * v[j][2] + v[j][3] * v[j][3]);
        s = wave_sum(s);
        const float rs = rsqrtf(s * (1.0f / DM) + EPS);
        v2u* o8 = (v2u*)(XB + (size_t)row * DM) + lane;
#pragma unroll
        for (int j = 0; j < 4; ++j) { v2u o; o.x = pk2(v[j][0], v[j][1]); o.y = pk2(v[j][2], v[j][3]); o8[64 * j] = o; }
        if (lane < 16) SS0[(size_t)row * 16 + lane] = s * (1.0f / 16.0f);
        float p[16];
#pragma unroll
        for (int c = 0; c < 16; ++c) { float a = 0.f;
#pragma unroll
            for (int j = 0; j < 4; ++j) { const f32x4 w = *(const LAS f32x4*)(w16 + c * 1024 + 4 * lane + 256 * j); a += (v[j][0] * w[0] + v[j][1] * w[1]) + (v[j][2] * w[2] + v[j][3] * w[3]); }
            p[c] = a; if ((c & 3) == 3) __builtin_amdgcn_sched_barrier(0); }
        float q8[8], r4[4], s2[2], t1;
        { const bool b = lane & 1;
#pragma unroll
          for (int i = 0; i < 8; ++i) { const float keep = b ? p[2 * i + 1] : p[2 * i], send = b ? p[2 * i] : p[2 * i + 1]; q8[i] = keep + __shfl_xor(send, 1); } }
        { const bool b = lane & 2;
#pragma unroll
          for (int i = 0; i < 4; ++i) { const float keep = b ? q8[2 * i + 1] : q8[2 * i], send = b ? q8[2 * i] : q8[2 * i + 1]; r4[i] = keep + __shfl_xor(send, 2); } }
        { const bool b = lane & 4;
#pragma unroll
          for (int i = 0; i < 2; ++i) { const float keep = b ? r4[2 * i + 1] : r4[2 * i], send = b ? r4[2 * i] : r4[2 * i + 1]; s2[i] = keep + __shfl_xor(send, 4); } }
        { const bool b = lane & 8; const float keep = b ? s2[1] : s2[0], send = b ? s2[0] : s2[1]; t1 = keep + __shfl_xor(send, 8); }
        t1 += __shfl_xor(t1, 16); t1 += __shfl_xor(t1, 32);
        if (lane < 16) BA[(size_t)row * 16 + lane] = t1 * rs;
    }
    __syncthreads();
    const TrJob jobs[2] = { { w_in, 4112, 0, DM, 4096, a_norm, (bf16*)(ws + WS_WIN), 0, 0 },
                            { (const float*)A.in[8], DM, 0, DM, DM, nullptr, (bf16*)(ws + WS_WOA), 0, 0 } };
    run_transposes<2>(F, jobs, lane);
}

__device__ __forceinline__ void phase_gdn_pre(const Frame& F, const Args& A) {
    unsigned char* ws = A.ws;
    const bf16* P = (const bf16*)(ws + WS_P); const float* BA = (const float*)(ws + WS_BA); float* CD = (float*)(ws + WS_CD);
    const float* conv_w = (const float*)A.in[4]; const float* a_log = (const float*)A.in[5]; const float* dt_bias = (const float*)A.in[6];
    bf16* Wg = (bf16*)(ws + WS_W); bf16* Ug = (bf16*)((unsigned char*)A.out + 32 * MiB);     bf16* QDg = (bf16*)(ws + WS_QD); bf16* KDTg = (bf16*)(ws + WS_KDT); bf16* INg = (bf16*)(ws + WS_IN);
    const int hw = F.wave >> 2, wv4 = F.wave & 3;
    LAS unsigned char* L = F.lds + hw * 71680;
    LAS unsigned char* Kn = L, *Qn = L + 17408, *KBGt = L + 34816, *VBt = L + 53248;
    LAS float* Lm = (LAS float*)Qn;
    LAS unsigned char* Tn = Kn;
    LAS float* sc_base = (LAS float*)(F.lds + 143360 + hw * 1024);
#define GDN_S1(unit_, dst_) do { const int ln_ = fresh_lane(); const int u_ = (unit_); const int h_ = (u_ >> 5) & 7, tok_ = (u_ >> 8) * SEQ + (u_ & 31) * 64 + ln_; \
        const float braw = BA[(size_t)tok_ * 16 + h_], araw = BA[(size_t)tok_ * 16 + 8 + h_]; \
        const float beta_ = 1.0f / (1.0f + expf(-braw)); const float xx = araw + dt_bias[h_]; \
        const float sp = fmaxf(xx, 0.f) + log1pf(expf(-fabsf(xx))); \
        float g = -expf(a_log[h_]) * sp; \
        _Pragma("unroll") for (int o = 1; o < 64; o <<= 1) { const float y = __shfl_up(g, o); if (ln_ >= o) g += y; } \
        (dst_)[ln_] = g; (dst_)[64 + ln_] = beta_; if (ln_ == 63) CD[u_] = expf(g); } while (0)
    if (wv4 == 0) GDN_S1(F.vcu * 2 + hw, sc_base);
    __syncthreads();
    for (int it = 0; it < 4; ++it) {
        const int lane = fresh_lane();
        const int r16 = lane & 15, q4 = lane >> 4, t = (wv4 << 6) | lane;
        const int unit = it * 512 + F.vcu * 2 + hw;
        int b = unit >> 8, h = (unit >> 5) & 7, ch = unit & 31; asm volatile("" : "+s"(b), "+s"(h), "+s"(ch));
        const int tok0 = b * SEQ + ch * 64;
        LAS float* sc = sc_base + (it & 1) * 128;
        {
            const int cg = lane & 15, rg = t >> 4, r0 = 4 * rg;
            float gcr[4], btr[4], egr[4], ekr[4]; const float glast = sc[63];
#pragma unroll
            for (int rr = 0; rr < 4; ++rr) { gcr[rr] = sc[r0 + rr]; btr[rr] = sc[64 + r0 + rr]; egr[rr] = __builtin_amdgcn_exp2f(1.4426950408889634f * gcr[rr]); ekr[rr] = __builtin_amdgcn_exp2f(1.4426950408889634f * (glast - gcr[rr])); }
            v4u xra[3][7];
#pragma unroll
            for (int seg = 0; seg < 3; ++seg)
#pragma unroll
                for (int li = 0; li < 7; ++li) { const int srow = ch * 64 + r0 + li - 3; const int crow = srow < 0 ? 0 : srow;
                    xra[seg][li] = __builtin_nontemporal_load((const v4u*)(P + (size_t)(b * SEQ + crow) * 3072 + seg * 1024 + h * 128 + cg * 8)); if (srow < 0) xra[seg][li] = (v4u){0u, 0u, 0u, 0u}; }
            f32x4 wvn[4][2];
#pragma unroll
            for (int j = 0; j < 4; ++j) { wvn[j][0] = *(const f32x4*)(conv_w + (size_t)j * 3072 + h * 128 + cg * 8); wvn[j][1] = *(const f32x4*)(conv_w + (size_t)j * 3072 + h * 128 + cg * 8 + 4); }
#pragma unroll
            for (int seg = 0; seg < 3; ++seg) {
                const int colbase = seg * 1024 + h * 128 + cg * 8;
                f32x4 wv[4][2];
#pragma unroll
                for (int j = 0; j < 4; ++j) { wv[j][0] = wvn[j][0]; wv[j][1] = wvn[j][1]; }
                if (seg < 2) {
#pragma unroll
                    for (int j = 0; j < 4; ++j) { wvn[j][0] = *(const f32x4*)(conv_w + (size_t)j * 3072 + colbase + 1024); wvn[j][1] = *(const f32x4*)(conv_w + (size_t)j * 3072 + colbase + 1024 + 4); } }
                float acc[4][8]; float ss[4];
#pragma unroll
                for (int rr = 0; rr < 4; ++rr) {
#pragma unroll
                    for (int e = 0; e < 8; ++e) acc[rr][e] = 0.f;
#pragma unroll
                    for (int j = 0; j < 4; ++j) { const v4u xv = xra[seg][rr + j];
                        acc[rr][0] += wv[j][0][0] * bflo(xv.x); acc[rr][1] += wv[j][0][1] * bfhi(xv.x); acc[rr][2] += wv[j][0][2] * bflo(xv.y); acc[rr][3] += wv[j][0][3] * bfhi(xv.y);
                        acc[rr][4] += wv[j][1][0] * bflo(xv.z); acc[rr][5] += wv[j][1][1] * bfhi(xv.z); acc[rr][6] += wv[j][1][2] * bflo(xv.w); acc[rr][7] += wv[j][1][3] * bfhi(xv.w); }
                    float s_ = 0.f;
#pragma unroll
                    for (int e = 0; e < 8; ++e) { const float v = acc[rr][e]; const float sv = v * __builtin_amdgcn_rcpf(1.0f + __builtin_amdgcn_exp2f(-1.4426950408889634f * v)); acc[rr][e] = sv; s_ += sv * sv; }
                    s_ += __shfl_xor(s_, 1); s_ += __shfl_xor(s_, 2); s_ += __shfl_xor(s_, 4); s_ += __shfl_xor(s_, 8);
                    ss[rr] = s_;
                }
                if (seg == 0) {
#pragma unroll
                    for (int rr = 0; rr < 4; ++rr) { const float s0 = rsqrtf(ss[rr] + EPS) * 0.08838834764831845f, eg = egr[rr]; v4u o, od;
                        const float a0 = acc[rr][0] * s0, a1 = acc[rr][1] * s0, a2 = acc[rr][2] * s0, a3 = acc[rr][3] * s0, a4 = acc[rr][4] * s0, a5 = acc[rr][5] * s0, a6 = acc[rr][6] * s0, a7 = acc[rr][7] * s0;
                        o.x = pk2(a0, a1); o.y = pk2(a2, a3); o.z = pk2(a4, a5); o.w = pk2(a6, a7);
                        od.x = pk2(a0 * eg, a1 * eg); od.y = pk2(a2 * eg, a3 * eg); od.z = pk2(a4 * eg, a5 * eg); od.w = pk2(a6 * eg, a7 * eg);
                        *(LAS v4u*)(Qn + (r0 + rr) * 272 + cg * 16) = o; *(v4u*)(QDg + (size_t)unit * 8192 + (r0 + rr) * 128 + cg * 8) = od; }
                } else if (seg == 1) {
                    float rn[4];
#pragma unroll
                    for (int rr = 0; rr < 4; ++rr) { rn[rr] = rsqrtf(ss[rr] + EPS); v4u o;
                        o.x = pk2(acc[rr][0] * rn[rr], acc[rr][1] * rn[rr]); o.y = pk2(acc[rr][2] * rn[rr], acc[rr][3] * rn[rr]); o.z = pk2(acc[rr][4] * rn[rr], acc[rr][5] * rn[rr]); o.w = pk2(acc[rr][6] * rn[rr], acc[rr][7] * rn[rr]);
                        *(LAS v4u*)(Kn + (r0 + rr) * 272 + cg * 16) = o; }
#pragma unroll
                    for (int e = 0; e < 8; ++e) { const int d = 8 * cg + e; const int so = ((((r0 >> 3) ^ (cg & 7))) << 4) + ((r0 & 4) << 1);
                        const float k0 = acc[0][e] * rn[0], k1 = acc[1][e] * rn[1], k2 = acc[2][e] * rn[2], k3 = acc[3][e] * rn[3];
                        v2u wb, wd; wb.x = pk2(k0 * btr[0] * egr[0], k1 * btr[1] * egr[1]); wb.y = pk2(k2 * btr[2] * egr[2], k3 * btr[3] * egr[3]);
                        wd.x = pk2(k0 * ekr[0], k1 * ekr[1]); wd.y = pk2(k2 * ekr[2], k3 * ekr[3]);
                        *(LAS v2u*)(KBGt + d * 144 + so) = wb; *(v2u*)(KDTg + (size_t)unit * 8192 + d * 64 + r0) = wd; }
                } else {
#pragma unroll
                    for (int e = 0; e < 8; ++e) { const int d = 8 * cg + e; const int so = ((((r0 >> 3) ^ (cg & 7))) << 4) + ((r0 & 4) << 1);
                        v2u wb; wb.x = pk2(acc[0][e] * btr[0], acc[1][e] * btr[1]); wb.y = pk2(acc[2][e] * btr[2], acc[3][e] * btr[3]);
                        *(LAS v2u*)(VBt + d * 144 + so) = wb; }
                }
            }
        }
        __syncthreads();
        {
            const int i = 16 * wv4 + r16; const float gci = sc[i];
#pragma unroll
            for (int jt = 0; jt < 4; ++jt) {
                f32x4 acc = {0.f, 0.f, 0.f, 0.f};
                if (jt <= wv4) {
#pragma unroll
                    for (int ks = 0; ks < 4; ++ks) { const bf16x8 a = *(const LAS bf16x8*)(Kn + (16 * jt + r16) * 272 + ks * 64 + q4 * 16); const bf16x8 bq = *(const LAS bf16x8*)(Qn + i * 272 + ks * 64 + q4 * 16);
                        acc = __builtin_amdgcn_mfma_f32_16x16x32_bf16(a, bq, acc, 0, 0, 0); }
                }
                float o[4];
#pragma unroll
                for (int e = 0; e < 4; ++e) { const int j = 16 * jt + 4 * q4 + e; o[e] = (j <= i) ? acc[e] * __builtin_amdgcn_exp2f(1.4426950408889634f * (gci - sc[j])) : 0.f; }
                v2u w; w.x = pk2(o[0], o[1]); w.y = pk2(o[2], o[3]);
                *(v2u*)(INg + (size_t)unit * 4096 + i * 64 + 16 * jt + 4 * q4) = w;
            }
        }
        __syncthreads();
        {
#pragma unroll
            for (int jt = 0; jt < 4; ++jt) {
                if (jt <= wv4) {
                    f32x4 acc = {0.f, 0.f, 0.f, 0.f};
#pragma unroll
                    for (int ks = 0; ks < 4; ++ks) { const bf16x8 a = *(const LAS bf16x8*)(Kn + (16 * wv4 + r16) * 272 + ks * 64 + q4 * 16); const bf16x8 bk = *(const LAS bf16x8*)(Kn + (16 * jt + r16) * 272 + ks * 64 + q4 * 16);
                        acc = __builtin_amdgcn_mfma_f32_16x16x32_bf16(a, bk, acc, 0, 0, 0); }
                    const int j = 16 * jt + r16; const float gcj = sc[j];
#pragma unroll
                    for (int e = 0; e < 4; ++e) { const int i = 16 * wv4 + 4 * q4 + e; Lm[i * 64 + j] = (j < i) ? sc[64 + i] * acc[e] * __builtin_amdgcn_exp2f(1.4426950408889634f * (sc[i] - gcj)) : 0.f; }
                }
            }
        }
        __syncthreads();
        if (wv4 == 1 && it < 3) GDN_S1((it + 1) * 512 + F.vcu * 2 + hw, sc_base + ((it + 1) & 1) * 128);
#ifndef NO_INV
        for (int rep5 = 0; rep5 < INV_REPS; ++rep5)
        if (wv4 == 0) {
            float tc[64]; int lane_o = lane; asm volatile("" : "+v"(lane_o));
            f32x4 lv[2][16];
#pragma unroll
            for (int i = 0; i < 64; ++i) {
                if (i + 1 < 64) {
#pragma unroll
                    for (int mq = 0; mq < (i + 1 + 3) / 4; ++mq) lv[(i + 1) & 1][mq] = *(const LAS f32x4*)(Lm + (i + 1) * 64 + 4 * mq);
                }
                __builtin_amdgcn_sched_barrier(0);
                float a0 = (lane_o == i) ? 1.f : 0.f, a1 = 0.f, a2 = 0.f, a3 = 0.f;
#pragma unroll
                for (int mq = 0; mq < (i + 3) / 4; ++mq) {
                    const f32x4 l4 = lv[i & 1][mq];
                    if (4 * mq + 0 < i) a0 -= l4[0] * tc[4 * mq + 0];
                    if (4 * mq + 1 < i) a1 -= l4[1] * tc[4 * mq + 1];
                    if (4 * mq + 2 < i) a2 -= l4[2] * tc[4 * mq + 2];
                    if (4 * mq + 3 < i) a3 -= l4[3] * tc[4 * mq + 3];
                }
                tc[i] = (a0 + a1) + (a2 + a3);
                asm volatile("" ::: "memory");
            }
#pragma unroll
            for (int i = 0; i < 64; ++i) *(LAS unsigned short*)(Tn + i * 144 + lane * 2) = f2bf1(tc[i]);
        }
#endif
        __syncthreads();
        {
#pragma unroll
            for (int which = 0; which < 2; ++which) {
                LAS unsigned char* Asrc = which ? VBt : KBGt; bf16* Og = (which ? Ug : Wg) + (size_t)unit * 8192;
#pragma unroll
                for (int dd = 0; dd < 2; ++dd) { const int dt = 2 * wv4 + dd;
                    const int dsw = (2 * dt + (r16 >> 3)) & 7;
                    const bf16x8 a0 = *(const LAS bf16x8*)(Asrc + (16 * dt + r16) * 144 + ((q4 ^ dsw) << 4)), a1 = *(const LAS bf16x8*)(Asrc + (16 * dt + r16) * 144 + (((4 + q4) ^ dsw) << 4));
#pragma unroll
                    for (int itl = 0; itl < 4; ++itl) {
                        const bf16x8 b0 = *(const LAS bf16x8*)(Tn + (16 * itl + r16) * 144 + q4 * 16), b1 = *(const LAS bf16x8*)(Tn + (16 * itl + r16) * 144 + 64 + q4 * 16);
                        f32x4 acc = {0.f, 0.f, 0.f, 0.f};
                        acc = __builtin_amdgcn_mfma_f32_16x16x32_bf16(a0, b0, acc, 0, 0, 0); acc = __builtin_amdgcn_mfma_f32_16x16x32_bf16(a1, b1, acc, 0, 0, 0);
                        v2u w; w.x = pk2(acc[0], acc[1]); w.y = pk2(acc[2], acc[3]);
                        *(v2u*)(Og + (16 * itl + r16) * 128 + 16 * dt + 4 * q4) = w; } }
            }
        }
        __syncthreads();
    }
}
__device__ __forceinline__ void phase_gdn_scan(const Frame& F, const Args& A) {
    unsigned char* ws = A.ws;
    const bf16* Wg = (const bf16*)(ws + WS_W); const bf16* Ug = (const bf16*)((unsigned char*)A.out + 32 * MiB); const bf16* QDg = (const bf16*)(ws + WS_QD); const bf16* KDTg = (const bf16*)(ws + WS_KDT); const bf16* INg = (const bf16*)(ws + WS_IN);
    const float* CD = (const float*)(ws + WS_CD);
    bf16* Oo = (bf16*)((unsigned char*)A.out + 32 * MiB);
    const int bh = F.vcu >> 2, sl = F.vcu & 3, b = bh >> 3, h = bh & 7, unit0 = bh * 32;
    const int lane = fresh_lane(), tid = F.wave * 64 + lane, r16 = lane & 15, q4 = lane >> 4, m = F.wave >> 1, n = F.wave & 1;
    constexpr int BUF = 62464, O_W = 0, O_QD = 17408, O_KDT = 34816, O_IN = 53248, O_S = 2 * BUF, O_VN = O_S + 8704, O_U = O_VN + 4608;
    LAS unsigned char* lds = F.lds;
    for (int e = tid; e < 8704 / 4; e += 512) ((LAS unsigned*)(lds + O_S))[e] = 0u;
    const int pW0 = tid, pW1 = tid + 512;
    const int lW0 = (pW0 >> 4) * 272 + (pW0 & 15) * 16, lW1 = (pW1 >> 4) * 272 + (pW1 & 15) * 16;
    const int lK0 = (pW0 >> 3) * 144 + (pW0 & 7) * 16, lK1 = (pW1 >> 3) * 144 + (pW1 & 7) * 16;
    const int lI = (tid >> 3) * 144 + (tid & 7) * 16;
    v4u rW[2][2], rQ[2][2], rK[2][2], rI[2], rU[2];
    const int urow = 16 * m + 4 * q4, ucol = 16 * n + r16;
    const float cdv = CD[unit0 + (lane & 31)];
#define SCAN_LOAD(u_, S_) do { const size_t ub = (size_t)(u_); \
        rW[S_][0] = *(const v4u*)(Wg + ub * 8192 + pW0 * 8); rW[S_][1] = *(const v4u*)(Wg + ub * 8192 + pW1 * 8); \
        rQ[S_][0] = *(const v4u*)(QDg + ub * 8192 + pW0 * 8); rQ[S_][1] = *(const v4u*)(QDg + ub * 8192 + pW1 * 8); \
        rK[S_][0] = *(const v4u*)(KDTg + ub * 8192 + pW0 * 8); rK[S_][1] = *(const v4u*)(KDTg + ub * 8192 + pW1 * 8); \
        rI[S_] = *(const v4u*)(INg + ub * 4096 + tid * 8); \
        rU[S_] = *(const v4u*)(Ug + ub * 8192 + ((tid & 255) >> 2) * 128 + sl * 32 + (tid & 3) * 8); } while (0)
#define SCAN_WRITE(bufo, S_) do { LAS unsigned char* bw = lds + (bufo); \
        *(LAS v4u*)(bw + O_W + lW0) = rW[S_][0]; *(LAS v4u*)(bw + O_W + lW1) = rW[S_][1]; *(LAS v4u*)(bw + O_QD + lW0) = rQ[S_][0]; *(LAS v4u*)(bw + O_QD + lW1) = rQ[S_][1]; \
        *(LAS v4u*)(bw + O_KDT + lK0) = rK[S_][0]; *(LAS v4u*)(bw + O_KDT + lK1) = rK[S_][1]; *(LAS v4u*)(bw + O_IN + lI) = rI[S_]; \
        *(LAS v4u*)(lds + O_U + ((tid & 255) >> 2) * 80 + (tid & 3) * 16) = rU[S_]; } while (0)
    SCAN_LOAD(unit0, 0);
    SCAN_WRITE(0, 0);
    SCAN_LOAD(unit0 + 1, 1);
    f32x4 Sa[2] = {{0.f, 0.f, 0.f, 0.f}, {0.f, 0.f, 0.f, 0.f}};
    __syncthreads();
#define SCAN_BODY(c, LS_, WS_) do { \
        const int bo = ((c) & 1) * BUF, bn = (((c) + 1) & 1) * BUF; \
        SCAN_LOAD(unit0 + ((c) + 2 < 32 ? (c) + 2 : 31), LS_);     \
        const float cd = __uint_as_float((unsigned)__builtin_amdgcn_readlane((int)__float_as_uint(cdv), (c))); \
        float ucur[4]; \
        _Pragma("unroll") for (int e = 0; e < 4; ++e) ucur[e] = __uint_as_float((unsigned)(*(const LAS unsigned short*)(lds + O_U + (urow + e) * 80 + ucol * 2)) << 16); \
        LAS unsigned char* bb = lds + bo; \
        f32x4 av = {0.f, 0.f, 0.f, 0.f}, ao = {0.f, 0.f, 0.f, 0.f}; \
        _Pragma("unroll") for (int ks = 0; ks < 4; ++ks) { \
            const bf16x8 sf = *(const LAS bf16x8*)(lds + O_S + (16 * n + r16) * 272 + ks * 64 + q4 * 16); \
            const bf16x8 af = *(const LAS bf16x8*)(bb + O_W + (16 * m + r16) * 272 + ks * 64 + q4 * 16); \
            const bf16x8 qf = *(const LAS bf16x8*)(bb + O_QD + (16 * m + r16) * 272 + ks * 64 + q4 * 16); \
            av = __builtin_amdgcn_mfma_f32_16x16x32_bf16(af, sf, av, 0, 0, 0); \
            ao = __builtin_amdgcn_mfma_f32_16x16x32_bf16(sf, qf, ao, 0, 0, 0); } \
        { v2u w; w.x = pk2(ucur[0] - av[0], ucur[1] - av[1]); w.y = pk2(ucur[2] - av[2], ucur[3] - av[3]); \
          *(LAS v2u*)(lds + O_VN + (16 * n + r16) * 144 + (16 * m + 4 * q4) * 2) = w; } \
        __syncthreads(); \
        Sa[0] = Sa[0] * cd; Sa[1] = Sa[1] * cd; \
        _Pragma("unroll") for (int ks = 0; ks < 2; ++ks) { \
            const bf16x8 vf = *(const LAS bf16x8*)(lds + O_VN + (16 * n + r16) * 144 + ks * 64 + q4 * 16); \
            const bf16x8 inf = *(const LAS bf16x8*)(bb + O_IN + (16 * m + r16) * 144 + ks * 64 + q4 * 16); \
            ao = __builtin_amdgcn_mfma_f32_16x16x32_bf16(vf, inf, ao, 0, 0, 0); \
            _Pragma("unroll") for (int tt = 0; tt < 2; ++tt) { const bf16x8 kf = *(const LAS bf16x8*)(bb + O_KDT + (16 * (2 * m + tt) + r16) * 144 + ks * 64 + q4 * 16); \
                Sa[tt] = __builtin_amdgcn_mfma_f32_16x16x32_bf16(kf, vf, Sa[tt], 0, 0, 0); } } \
        { v2u w; w.x = pk2(ao[0], ao[1]); w.y = pk2(ao[2], ao[3]); \
          *(v2u*)(Oo + (size_t)(unit0 + (c)) * 8192 + (16 * m + r16) * 128 + sl * 32 + 16 * n + 4 * q4) = w; }     \
        _Pragma("unroll") for (int tt = 0; tt < 2; ++tt) { v2u w; w.x = pk2(Sa[tt][0], Sa[tt][1]); w.y = pk2(Sa[tt][2], Sa[tt][3]); \
            *(LAS v2u*)(lds + O_S + (16 * n + r16) * 272 + (16 * (2 * m + tt) + 4 * q4) * 2) = w; } \
        SCAN_WRITE(bn, WS_); \
        __syncthreads(); } while (0)
#pragma unroll 1
    for (int c = 0; c < 32; c += 2) { SCAN_BODY(c, 0, 1); SCAN_BODY(c + 1, 1, 0); }
#undef SCAN_BODY
#undef SCAN_LOAD
#undef SCAN_WRITE
}

__device__ const float ROPE_FREQ[32] = {1.000000000e+00f, 7.498942614e-01f, 5.623413324e-01f, 4.216965139e-01f, 3.162277639e-01f, 2.371373773e-01f, 1.778279394e-01f, 1.333521307e-01f, 1.000000015e-01f, 7.498941571e-02f, 5.623413250e-02f, 4.216965288e-02f, 3.162277490e-02f, 2.371373773e-02f, 1.778279431e-02f, 1.333521493e-02f, 9.999999776e-03f, 7.498941850e-03f, 5.623413250e-03f, 4.216964822e-03f, 3.162277630e-03f, 2.371373586e-03f, 1.778279431e-03f, 1.333521446e-03f, 1.000000047e-03f, 7.498942432e-04f, 5.623413017e-04f, 4.216965172e-04f, 3.162277571e-04f, 2.371373703e-04f, 1.778279402e-04f, 1.333521504e-04f};
__device__ __forceinline__ void phase_gate(const Frame& F, const Args& A) {
    unsigned char* ws = A.ws;
    const bf16* Z = (const bf16*)A.out; const bf16* Oo = (const bf16*)((unsigned char*)A.out + 32 * MiB); bf16* OG = (bf16*)(ws + WS_OG);
    const float* out_norm = (const float*)A.in[7];
    const int gw = F.vcu * NWAVES + F.wave, NGW = F.G * NWAVES, lane = fresh_lane();
    float wn[8];
#pragma unroll
    for (int e = 0; e < 8; ++e) wn[e] = out_norm[((lane * 8) & 127) + e];
#define OADDR(row_, col_) ((size_t)((((row_) >> 11) * 8 + ((col_) >> 7)) * 32 + (((row_) >> 6) & 31)) * 8192 + ((row_) & 63) * 128 + ((col_) & 127))
    v4u on_[2], zn_[2];
#pragma unroll
    for (int j = 0; j < 2; ++j) { on_[j] = __builtin_nontemporal_load((const v4u*)(Oo + OADDR(gw, lane * 8 + 512 * j))); zn_[j] = __builtin_nontemporal_load((const v4u*)(Z + (size_t)gw * DM + lane * 8 + 512 * j)); }
    for (int row = gw; row < M; row += NGW) {
        v4u oc_[2], zc_[2];
#pragma unroll
        for (int j = 0; j < 2; ++j) { oc_[j] = on_[j]; zc_[j] = zn_[j]; }
        { const int nrow = (row + NGW < M) ? row + NGW : row;
#pragma unroll
          for (int j = 0; j < 2; ++j) { on_[j] = __builtin_nontemporal_load((const v4u*)(Oo + OADDR(nrow, lane * 8 + 512 * j))); zn_[j] = __builtin_nontemporal_load((const v4u*)(Z + (size_t)nrow * DM + lane * 8 + 512 * j)); } }
#pragma unroll
        for (int j = 0; j < 2; ++j) { const int col = lane * 8 + 512 * j;
            const v4u o8 = oc_[j], z8 = zc_[j];
            float o[8] = {bflo(o8.x), bfhi(o8.x), bflo(o8.y), bfhi(o8.y), bflo(o8.z), bfhi(o8.z), bflo(o8.w), bfhi(o8.w)};
            float z[8] = {bflo(z8.x), bfhi(z8.x), bflo(z8.y), bfhi(z8.y), bflo(z8.z), bfhi(z8.z), bflo(z8.w), bfhi(z8.w)};
            float ss = 0.f;
#pragma unroll
            for (int e = 0; e < 8; ++e) ss += o[e] * o[e];
            ss += __shfl_xor(ss, 1); ss += __shfl_xor(ss, 2); ss += __shfl_xor(ss, 4); ss += __shfl_xor(ss, 8);
            const float rs = rsqrtf(ss * (1.0f / 128.0f) + EPS);
            float y[8];
#pragma unroll
            for (int e = 0; e < 8; ++e) y[e] = o[e] * rs * wn[e] * (z[e] * __builtin_amdgcn_rcpf(1.0f + __builtin_amdgcn_exp2f(-1.4426950408889634f * z[e])));
            v4u w; w.x = pk2(y[0], y[1]); w.y = pk2(y[2], y[3]); w.z = pk2(y[4], y[5]); w.w = pk2(y[6], y[7]);
            *(v4u*)(OG + (size_t)row * DM + col) = w; }
    }
    {
      float* RT = (float*)(ws + WS_ROPE); const int* positions = (const int*)A.in[1]; const float fq_ = ROPE_FREQ[lane & 31];
      for (int row = 2 * gw + (lane >> 5); row < M; row += 2 * NGW) { const float ang = (float)positions[row] * fq_;
          double rv = (double)ang * 0.15915494309189535; rv -= __builtin_rint(rv);
          f32x2_g o; o.x = __builtin_amdgcn_cosf((float)rv); o.y = __builtin_amdgcn_sinf((float)rv); *(f32x2_g*)(RT + (size_t)row * 64 + 2 * (lane & 31)) = o; } }
    const float* mlp_norm = (const float*)A.in[18]; const float* w1 = (const float*)A.in[19]; const float* w2 = (const float*)A.in[20];
    const TrJob jobs[8] = { { w1, FF, 0, DM, FF, mlp_norm, (bf16*)(ws + WS_W10), 0, 0 },
                            { w2, DM, 0, FF, DM, nullptr, (bf16*)(ws + WS_W20), 0, 0 },
                            { (const float*)A.in[10], 2048, 0, DM, 1024, (const float*)A.in[9], (bf16*)(ws + WS_WKVQ), 0, 1 },
                            { (const float*)A.in[10], 2048, 1024, DM, 1024, (const float*)A.in[9], (bf16*)(ws + WS_WKVQ), 1024, 0 },
                            { (const float*)A.in[13], DM, 0, DM, DM, (const float*)A.in[12], (bf16*)(ws + WS_WKVQ), 2048, 1 },
                            { (const float*)A.in[17], DM, 0, DM, DM, nullptr, (bf16*)(ws + WS_WOB), 0, 0 },
                            { w1 + (size_t)DM * FF, FF, 0, DM, FF, mlp_norm + DM, (bf16*)(ws + WS_W11), 0, 0 },
                            { w2 + (size_t)FF * DM, DM, 0, FF, DM, nullptr, (bf16*)(ws + WS_W21), 0, 0 } };
    run_transposes<8>(F, jobs, lane);
}

__device__ __forceinline__ void phase_normrope(const Frame& F, const Args& A) {
    bf16* KVQ = (bf16*)(A.ws + WS_KVQ); const int* positions = (const int*)A.in[1];
    const float* k_norm = (const float*)A.in[11]; const float* q_norm = (const float*)A.in[14];
    const int gw = F.vcu * NWAVES + F.wave, NGW = F.G * NWAVES, lane = fresh_lane(), dq = lane & 15, gs = lane >> 4, d0 = 2 * dq;
    const float f0 = ROPE_FREQ[d0], f1 = ROPE_FREQ[d0 + 1];
    const float kw0 = k_norm[d0], kw1 = k_norm[d0 + 1], kw2 = k_norm[32 + d0], kw3 = k_norm[33 + d0];
    const float qw0 = q_norm[d0], qw1 = q_norm[d0 + 1], qw2 = q_norm[32 + d0], qw3 = q_norm[33 + d0];
    constexpr float C2 = 0.125f * 1.4426950408889634f;
    for (int row = gw; row < M; row += NGW) {
        const float pos = (float)positions[row];
        const float a0 = pos * f0, a1 = pos * f1;
        double r0 = (double)a0 * 0.15915494309189535, r1 = (double)a1 * 0.15915494309189535;
        r0 -= __builtin_rint(r0); r1 -= __builtin_rint(r1);
        const float c0 = __builtin_amdgcn_cosf((float)r0), s0 = __builtin_amdgcn_sinf((float)r0), c1 = __builtin_amdgcn_cosf((float)r1), s1 = __builtin_amdgcn_sinf((float)r1);
        unsigned u1[2][4], u2[2][4];
#pragma unroll
        for (int part = 0; part < 2; ++part)
#pragma unroll
            for (int it = 0; it < 4; ++it) { const bf16* base = KVQ + (size_t)row * 3072 + part * 2048 + (4 * it + gs) * 64 + d0; u1[part][it] = *(const unsigned*)base; u2[part][it] = *(const unsigned*)(base + 32); }
#pragma unroll
        for (int part = 0; part < 2; ++part) {
            bf16* base = KVQ + (size_t)row * 3072 + part * 2048;
            const float w0 = part ? qw0 : kw0, w1 = part ? qw1 : kw1, w2 = part ? qw2 : kw2, w3 = part ? qw3 : kw3, osc = part ? C2 : 1.0f;
#pragma unroll
            for (int it = 0; it < 4; ++it) { const int g = 4 * it + gs;
                unsigned* p1 = (unsigned*)(base + g * 64 + d0); unsigned* p2 = (unsigned*)(base + g * 64 + 32 + d0);
                const unsigned a1 = u1[part][it], a2 = u2[part][it];
                const float t10 = bflo(a1), t11 = bfhi(a1), t20 = bflo(a2), t21 = bfhi(a2);
                float ss = (t10 * t10 + t11 * t11) + (t20 * t20 + t21 * t21);
                ss += __shfl_xor(ss, 1); ss += __shfl_xor(ss, 2); ss += __shfl_xor(ss, 4); ss += __shfl_xor(ss, 8);
                const float rs = rsqrtf(ss * (1.0f / 64.0f) + EPS) * osc;
                const float y10 = t10 * rs * w0, y11 = t11 * rs * w1, y20 = t20 * rs * w2, y21 = t21 * rs * w3;
                *p1 = pk2(y10 * c0 - y20 * s0, y11 * c1 - y21 * s1); *p2 = pk2(y20 * c0 + y10 * s0, y21 * c1 + y11 * s1); }
        }
    }
}

__device__ __forceinline__ void phase_combine(const Frame& F, const Args& A) {
    const bf16* AO = (const bf16*)(A.ws + WS_AO); bf16* OD = (bf16*)(A.ws + WS_OD);
    const float* lp = (const float*)A.in[15]; const float* sub_norm = (const float*)A.in[16];
    const int gw = F.vcu * NWAVES + F.wave, NGW = F.G * NWAVES, lane = fresh_lane();
    constexpr float LAM_INIT = 0.35550906759096934f;
    const float s0 = wave_sum(lp[lane] * lp[64 + lane]), s1 = wave_sum(lp[128 + lane] * lp[192 + lane]);
    const float lam = expf(s0) - expf(s1) + LAM_INIT;
    float wn[8];
#pragma unroll
    for (int e = 0; e < 8; ++e) wn[e] = sub_norm[((lane * 8) & 127) + e] * (1.0f - LAM_INIT);
    v4u an_[2], bn_[2];
#pragma unroll
    for (int j = 0; j < 2; ++j) { const int col = lane * 8 + 512 * j, hh = col >> 7, d = col & 127; an_[j] = *(const v4u*)(AO + (size_t)gw * 2048 + hh * 256 + d); bn_[j] = *(const v4u*)(AO + (size_t)gw * 2048 + hh * 256 + 128 + d); }
    for (int row = gw; row < M; row += NGW) {
        v4u ac_[2], bc_[2];
#pragma unroll
        for (int j = 0; j < 2; ++j) { ac_[j] = an_[j]; bc_[j] = bn_[j]; }
        { const int nrow = (row + NGW < M) ? row + NGW : row;
#pragma unroll
          for (int j = 0; j < 2; ++j) { const int col = lane * 8 + 512 * j, hh = col >> 7, d = col & 127; an_[j] = *(const v4u*)(AO + (size_t)nrow * 2048 + hh * 256 + d); bn_[j] = *(const v4u*)(AO + (size_t)nrow * 2048 + hh * 256 + 128 + d); } }
#pragma unroll
        for (int j = 0; j < 2; ++j) { const int col = lane * 8 + 512 * j;
            const v4u a8 = ac_[j], b8 = bc_[j];
            float x[8] = {bflo(a8.x) - lam * bflo(b8.x), bfhi(a8.x) - lam * bfhi(b8.x), bflo(a8.y) - lam * bflo(b8.y), bfhi(a8.y) - lam * bfhi(b8.y),
                          bflo(a8.z) - lam * bflo(b8.z), bfhi(a8.z) - lam * bfhi(b8.z), bflo(a8.w) - lam * bflo(b8.w), bfhi(a8.w) - lam * bfhi(b8.w)};
            float ss = 0.f;
#pragma unroll
            for (int e = 0; e < 8; ++e) ss += x[e] * x[e];
            ss += __shfl_xor(ss, 1); ss += __shfl_xor(ss, 2); ss += __shfl_xor(ss, 4); ss += __shfl_xor(ss, 8);
            const float rs = rsqrtf(ss * (1.0f / 128.0f) + EPS);
            v4u w; w.x = pk2(x[0] * rs * wn[0], x[1] * rs * wn[1]); w.y = pk2(x[2] * rs * wn[2], x[3] * rs * wn[3]); w.z = pk2(x[4] * rs * wn[4], x[5] * rs * wn[5]); w.w = pk2(x[6] * rs * wn[6], x[7] * rs * wn[7]);
            *(v4u*)(OD + (size_t)row * DM + col) = w; }
    }
}

constexpr int LDS_RSB = 131072;
__device__ __forceinline__ void prep_rs(const Frame& F, const float* ss, const pg8::StaticOrder& S, const float* kn = nullptr, const float* qn = nullptr) {
    const int lane = fresh_lane(), tid = F.wave * 64 + lane; LAS float* rsb = (LAS float*)(F.lds + LDS_RSB);
    if (kn && tid >= 256 && tid < 384) rsb[1024 + tid - 256] = (tid < 320) ? kn[tid - 256] : qn[tid - 320];
    if (tid < 256) {
#pragma unroll
        for (int i = 0; i < 4; ++i) { pg8::Unit u; if (S.next(i, u)) rsb[i * 256 + tid] = pg8::row_rs(ss, u.pm * 256 + tid); }
    }
    __syncthreads();
}
#ifndef PH_MASK
#define PH_MASK 0xffffffffu
#endif
#define PH(k) ((PH_MASK >> (k)) & 1u)
#ifndef DUP_MASK
#define DUP_MASK 0u
#endif
#ifndef SYNC_EXTRA
#define SYNC_EXTRA 0
#endif
#define GSYNC(k) xcd_barrier(bar)
#define RUN(k, ...) for (int rep_ = 0; rep_ < 1 + (int)((DUP_MASK >> (k)) & 1u); ++rep_) { if (PH(k)) { __VA_ARGS__; } if ((k) != 14 || rep_ == 0 && ((DUP_MASK >> 14) & 1u)) GSYNC(k); }
__global__ void __launch_bounds__(NWAVES * 64, 2) yoco_fwd(Args args) {
    extern __shared__ __attribute__((aligned(16))) unsigned char lds_raw[];
    cg::grid_group grid = cg::this_grid();
    Frame F; F.lds = (LAS unsigned char*)lds_raw; F.wave = __builtin_amdgcn_readfirstlane((int)threadIdx.x >> 6);
    F.G = gridDim.x; { const int bx = blockIdx.x; F.vcu = (F.G % 8 == 0) ? (bx % 8) * (F.G / 8) + bx / 8 : bx; }
    unsigned char* ws = args.ws;
    float* SS0 = (float*)(ws + WS_SS); float* SS1 = SS0 + (size_t)M * 16; float* SS2 = SS1 + (size_t)M * 16; float* SS3 = SS2 + (size_t)M * 16;
    bf16* XB = (bf16*)(ws + WS_XB);
    float* out = args.out;
    { volatile LAS unsigned* st = (volatile LAS unsigned*)(F.lds + LDS_BARST); if (xb_tid0()) { st[0] = 0u; st[1] = 0u; } }
    __syncthreads();
    XcdBarrier bar = xcd_barrier_post((unsigned*)(ws + WS_BAR), (volatile LAS unsigned*)(F.lds + LDS_BARST));
    for (int e_ = 0; e_ < SYNC_EXTRA; ++e_) xcd_barrier(bar);
    if (F.G != 256) grid.sync();
    RUN(0, phase_prologue(F, args);)
    RUN(1, { pg8::Gemm g{XB, (const bf16*)(ws + WS_WIN), M, 4096, DM}; pg8::StaticOrder S; S.init(M, 4096, F.G, (int)blockIdx.x);
      prep_rs(F, SS0, S);
      pg8::EpiScaleBf16<0> E{(bf16*)(ws + WS_P), 3072, (bf16*)out, 1024, 12, (const LAS float*)(F.lds + LDS_RSB)};
      pg8::gemm_phase<pg8::EpiScaleBf16<0>, pg8::StaticOrder, true, true>(F.lds, g, S, E, F.wave); })
    RUN(2, phase_gdn_pre(F, args);)
    RUN(3, phase_gdn_scan(F, args);)
    RUN(4, phase_gate(F, args);)
    RUN(5, { pg8::Gemm g{(const bf16*)(ws + WS_OG), (const bf16*)(ws + WS_WOA), M, DM, DM}; pg8::StaticOrder S; S.init(M, DM, F.G, (int)blockIdx.x);
      pg8::EpiResid<true, false, true> E{XB, nullptr, XB, SS1};
      pg8::gemm_phase<pg8::EpiResid<true, false, true>, pg8::StaticOrder, true, true>(F.lds, g, S, E, F.wave); })
    RUN(6, { pg8::Gemm g{XB, (const bf16*)(ws + WS_W10), M, FF, DM}; pg8::StaticOrder S; S.init(M, FF, F.G, (int)blockIdx.x);
      prep_rs(F, SS1, S);
      pg8::EpiScaleBf16<1> E{(bf16*)(ws + WS_H), FF, nullptr, 0, 1 << 30, (const LAS float*)(F.lds + LDS_RSB)};
      pg8::gemm_phase<pg8::EpiScaleBf16<1>, pg8::StaticOrder, true, true>(F.lds, g, S, E, F.wave); })
    RUN(7, { pg8::Gemm g{(const bf16*)(ws + WS_H), (const bf16*)(ws + WS_W20), M, DM, FF}; pg8::StaticOrder S; S.init(M, DM, F.G, (int)blockIdx.x);
      pg8::EpiResid<true, false, true> E{XB, nullptr, XB, SS2};
      pg8::gemm_phase<pg8::EpiResid<true, false, true>, pg8::StaticOrder, true, true>(F.lds, g, S, E, F.wave); })
    RUN(8, { pg8::Gemm g{XB, (const bf16*)(ws + WS_WKVQ), M, 3072, DM}; pg8::StaticOrder S; S.init(M, 3072, F.G, (int)blockIdx.x);
      prep_rs(F, SS2, S, (const float*)args.in[11], (const float*)args.in[14]);
      pg8::EpiKVQ E{(bf16*)(ws + WS_KVQ), (const LAS float*)(F.lds + LDS_RSB), (const float*)(ws + WS_ROPE), (const float*)args.in[11], (const float*)args.in[14]};
      pg8::gemm_phase<pg8::EpiKVQ, pg8::StaticOrder, true, true>(F.lds, g, S, E, F.wave); })
    RUN(10, { const int bh = F.vcu >> 2, sp = F.vcu & 3, b = bh >> 3, h = bh & 7;
      const attn_body::bf16* KVQ = (const attn_body::bf16*)(ws + WS_KVQ); attn_body::bf16* OD = (attn_body::bf16*)out + h * 128;
      constexpr float LAM_INIT = 0.35550906759096934f;
      const float* lp = (const float*)args.in[15]; const float* subn = (const float*)args.in[16];
      float lam; { const int ln = fresh_lane(); const float s0 = wave_sum(lp[ln] * lp[64 + ln]), s1 = wave_sum(lp[128 + ln] * lp[192 + ln]); lam = expf(s0) - expf(s1) + LAM_INIT; }
      LAS float* subw = (LAS float*)(F.lds + 120 * 1024);
      { const int ln = fresh_lane(); if (F.wave == 0) { subw[ln] = subn[ln] * (1.0f - LAM_INIT); subw[64 + ln] = subn[64 + ln] * (1.0f - LAM_INIT); } }
      __syncthreads();
      for (int qi = 0; qi < 2; ++qi) { const int qb = qi ? sp : 7 - sp;
          for (int su = 0; su < 4; ++su) { const int mm = su >> 1, hf = su & 1;
              attn_body::attn_unit<8>(b, F.wave, qb, KVQ + 2048 + (2 * h + mm) * 64, KVQ + (2 * h + mm) * 64, KVQ + 1024 + h * 128 + hf * 64, OD, (char*)lds_raw, mm, hf, lam, su == 3, (const float*)(lds_raw + 120 * 1024)); } } })
    RUN(12, { pg8::Gemm g{(const bf16*)out, (const bf16*)(ws + WS_WOB), M, DM, DM}; pg8::StaticOrder S; S.init(M, DM, F.G, (int)blockIdx.x);
      pg8::EpiResid<true, false, true> E{XB, nullptr, (bf16*)(ws + WS_X3B), SS3};
      pg8::gemm_phase<pg8::EpiResid<true, false, true>, pg8::StaticOrder, true, true>(F.lds, g, S, E, F.wave); })
    RUN(13, { pg8::Gemm g{(const bf16*)(ws + WS_X3B), (const bf16*)(ws + WS_W11), M, FF, DM}; pg8::StaticOrder S; S.init(M, FF, F.G, (int)blockIdx.x);
      prep_rs(F, SS3, S);
      pg8::EpiScaleBf16<1> E{(bf16*)(ws + WS_H), FF, nullptr, 0, 1 << 30, (const LAS float*)(F.lds + LDS_RSB)};
      pg8::gemm_phase<pg8::EpiScaleBf16<1>, pg8::StaticOrder, true, true>(F.lds, g, S, E, F.wave); })
    RUN(14, { pg8::Gemm g{(const bf16*)(ws + WS_H), (const bf16*)(ws + WS_W21), M, DM, FF}; pg8::StaticOrder S; S.init(M, DM, F.G, (int)blockIdx.x);
      pg8::EpiResid<true, true, false> E{(const bf16*)(ws + WS_X3B), out, nullptr, nullptr};
      pg8::gemm_phase<pg8::EpiResid<true, true, false>, pg8::StaticOrder, true, true>(F.lds, g, S, E, F.wave); })
}

extern "C" void kernel_launch(void* const* d_in, const int* in_sizes, int n_in, void* d_out, int out_size, void* d_ws, size_t ws_size, hipStream_t stream) {
    static int ready = 0;
    if (ready == 0) {
        if (n_in != 21 || out_size != M * DM || ws_size < WS_END) { fprintf(stderr, "kernel_launch: unexpected shapes (n_in %d out %d ws %zu)\n", n_in, out_size, ws_size); ready = -1; return; }
        if (hipFuncSetAttribute((const void*)yoco_fwd, hipFuncAttributeMaxDynamicSharedMemorySize, LDS_BYTES) != hipSuccess) { fprintf(stderr, "kernel_launch: hipFuncSetAttribute failed\n"); ready = -1; return; }
        int per_cu = 0; (void)hipOccupancyMaxActiveBlocksPerMultiprocessor(&per_cu, (const void*)yoco_fwd, NWAVES * 64, LDS_BYTES); (void)hipGetLastError();
        if (per_cu < 1) fprintf(stderr, "kernel_launch: occupancy query reports %d blocks per CU\n", per_cu);
        ready = 1;
    }
    if (ready < 0) return;
    Args a{};
    for (int i = 0; i < 21; ++i) a.in[i] = d_in[i];
    a.out = (float*)d_out; a.ws = (unsigned char*)d_ws;
    if (hipMemsetAsync((char*)d_ws + WS_BAR, 0, 16384, stream) != hipSuccess) { fprintf(stderr, "kernel_launch: memset of the barrier words failed\n"); return; }
    void* kargs[] = { &a };
    hipError_t e = hipLaunchCooperativeKernel((const void*)yoco_fwd, dim3(256), dim3(NWAVES * 64), kargs, LDS_BYTES, stream);
    if (e != hipSuccess) fprintf(stderr, "cooperative launch failed: %s\n", hipGetErrorString(e));
}
```
